# Optimizing an MI355X kernel written in HIP

```python
import jax, jax.numpy as jnp
from jax import lax
import numpy as np

D_MODEL = 1024
BATCH = 16
SEQ = 2048
DEPTH = 4

N_MIXERS = 2
N_HEADS = 16
HEAD_DIM = D_MODEL // N_HEADS
RMS_EPS = 1e-6
NEG = -1e30
BIG = 1e30
NSA_KV_GROUPS = 4
NSA_HPG = N_HEADS // NSA_KV_GROUPS
KV_W = NSA_KV_GROUPS * HEAD_DIM
CMP_BLOCK = 32
CMP_STRIDE = 16
CMP_HIDDEN = 4 * HEAD_DIM
SLC_BLOCK = 64
N_SLC_BLOCKS = 8
WINDOW = 512
NSA_QBLOCK = 32
N_BRANCH = 3
NSA_IN_W = D_MODEL + 6 * KV_W + N_BRANCH * N_HEADS
SB_QBLOCK = 128
D_FF = ((8 * D_MODEL // 3 + 255) // 256) * 256
N_NSA_LAYERS = (DEPTH + 1) // 2
N_SB_LAYERS = DEPTH // 2

kernel_name = "nsa_stickbreaking_interleaved_trunk"


def _alibi_slopes(n):
    return jnp.asarray(2.0 ** (-8.0 * (np.arange(n) + 1) / n), dtype=jnp.float32)


def _rmsnorm(x, g):
    xf = x.astype(jnp.float32)
    y = xf * lax.rsqrt(jnp.mean(xf * xf, axis=-1, keepdims=True) + RMS_EPS)
    return (y * g.astype(jnp.float32)).astype(x.dtype)


def _swiglu(h, w1, w3, w2):
    return (jax.nn.silu(h @ w1) * (h @ w3)) @ w2


def _compress(kv, pe, w1, w2):
    b, s, g, dh = kv.shape
    r = CMP_BLOCK // CMP_STRIDE
    nch = s // CMP_STRIDE
    nc = nch - r + 1
    ch = kv.reshape(b, nch, CMP_STRIDE, g, dh)
    blk = jnp.concatenate([ch[:, i:i + nc] for i in range(r)], axis=2)
    blk = blk + pe[None, None, :, None, :]
    flat = jnp.moveaxis(blk, 3, 2).reshape(b, nc, g, CMP_BLOCK * dh)
    return jax.nn.gelu(flat @ w1) @ w2


def _cmp_to_slc_matrix(n_cmp, n_slc):
    cs = np.arange(n_cmp) * CMP_STRIDE
    ce = cs + CMP_BLOCK
    ss = np.arange(n_slc) * SLC_BLOCK
    se = ss + SLC_BLOCK
    ov = np.clip(np.minimum(ce[:, None], se[None]) - np.maximum(cs[:, None], ss[None]), 0, None)
    return jnp.asarray(ov / CMP_STRIDE, dtype=jnp.float32)


def _gather_blocks(blk, idx):
    return jax.vmap(jax.vmap(lambda kb, ib: kb[ib]))(blk, idx)


def _nsa_mixer(h, w_in, gate_b, cmp_pe, cmp_w1, cmp_w2, w_out, slopes):
    b, s, d = h.shape
    g_, hpg, dh = NSA_KV_GROUPS, NSA_HPG, HEAD_DIM
    proj = h @ w_in
    cuts = np.cumsum([d, KV_W, KV_W, KV_W, KV_W, KV_W, KV_W]).tolist()
    q, kc, vc, ksl, vsl, kw, vw, gt = jnp.split(proj, cuts, axis=-1)
    q = q.reshape(b, s, g_, hpg, dh) * (dh ** -0.5)
    gates = jax.nn.sigmoid(gt + gate_b).reshape(b, s, N_BRANCH, g_, hpg)
    kc = _compress(kc.reshape(b, s, g_, dh), cmp_pe[0], cmp_w1[0], cmp_w2[0])
    vc = _compress(vc.reshape(b, s, g_, dh), cmp_pe[1], cmp_w1[1], cmp_w2[1])
    n_cmp = kc.shape[1]
    n_slcb = s // SLC_BLOCK
    n_sel = min(N_SLC_BLOCKS, n_slcb)
    cmap = _cmp_to_slc_matrix(n_cmp, n_slcb)
    c_end = jnp.arange(n_cmp) * CMP_STRIDE + CMP_BLOCK - 1
    ks_blk = jnp.transpose(ksl.reshape(b, n_slcb, SLC_BLOCK, g_, dh), (0, 3, 1, 2, 4))
    vs_blk = jnp.transpose(vsl.reshape(b, n_slcb, SLC_BLOCK, g_, dh), (0, 3, 1, 2, 4))
    pad = ((0, 0), (WINDOW, 0), (0, 0), (0, 0))
    kw_pad = jnp.pad(kw.reshape(b, s, g_, dh), pad)
    vw_pad = jnp.pad(vw.reshape(b, s, g_, dh), pad)
    sl = slopes.reshape(g_, hpg)
    qb = NSA_QBLOCK

    def step(c):
        qs = c * qb
        qc = lax.dynamic_slice_in_dim(q, qs, qb, axis=1)
        gc = lax.dynamic_slice_in_dim(gates, qs, qb, axis=1)
        t = qs + jnp.arange(qb)
        dist_c = t[:, None] - c_end[None]
        valid_c = dist_c >= 0
        s_c = jnp.einsum('bqghd,bngd->bghqn', qc, kc, preferred_element_type=jnp.float32)
        s_c = s_c - sl[None, :, :, None, None] * dist_c.astype(jnp.float32)
        p_c = jax.nn.softmax(jnp.where(valid_c, s_c, NEG), axis=-1) * valid_c
        o_c = jnp.einsum('bghqn,bngd->bqghd', p_c.astype(vc.dtype), vc)
        imp = jnp.einsum('bghqn,nj->bgqj', p_c, cmap)
        cur = t // SLC_BLOCK
        jb = jnp.arange(n_slcb)
        causal_j = jb[None] <= cur[:, None]
        forced = (jb[None] == 0) | (jb[None] == cur[:, None]) | (jb[None] == cur[:, None] - 1)
        imp = jnp.where(causal_j & forced, BIG, jnp.where(causal_j, imp, -BIG))
        _, idx = lax.top_k(imp, n_sel)
        blk_ok = idx <= cur[None, None, :, None]
        k_sel = _gather_blocks(ks_blk, idx)
        v_sel = _gather_blocks(vs_blk, idx)
        pos_s = idx[..., None] * SLC_BLOCK + jnp.arange(SLC_BLOCK)
        dist_s = t[None, None, :, None, None] - pos_s
        valid_s = ((dist_s >= 0) & blk_ok[..., None])[:, :, None]
        s_s = jnp.einsum('bqghd,bgqnkd->bghqnk', qc, k_sel, preferred_element_type=jnp.float32)
        s_s = s_s - sl[None, :, :, None, None, None] * dist_s[:, :, None].astype(jnp.float32)
        s_s = jnp.where(valid_s, s_s, NEG)
        p_s = jax.nn.softmax(s_s.reshape(b, g_, hpg, qb, n_sel * SLC_BLOCK), axis=-1)
        p_s = p_s.reshape(s_s.shape) * valid_s
        o_s = jnp.einsum('bghqnk,bgqnkd->bqghd', p_s.astype(v_sel.dtype), v_sel)
        kwc = lax.dynamic_slice_in_dim(kw_pad, qs, WINDOW + qb, axis=1)
        vwc = lax.dynamic_slice_in_dim(vw_pad, qs, WINDOW + qb, axis=1)
        pos_w = qs - WINDOW + jnp.arange(WINDOW + qb)
        dist_w = t[:, None] - pos_w[None]
        valid_w = (dist_w >= 0) & (dist_w < WINDOW) & (pos_w[None] >= 0)
        s_w = jnp.einsum('bqghd,bkgd->bghqk', qc, kwc, preferred_element_type=jnp.float32)
        s_w = s_w - sl[None, :, :, None, None] * dist_w.astype(jnp.float32)
        p_w = jax.nn.softmax(jnp.where(valid_w, s_w, NEG), axis=-1)
        o_w = jnp.einsum('bghqk,bkgd->bqghd', p_w.astype(vwc.dtype), vwc)
        return (gc[:, :, 0, :, :, None] * o_c + gc[:, :, 1, :, :, None] * o_s
                + gc[:, :, 2, :, :, None] * o_w)

    outs = lax.map(step, jnp.arange(s // qb))
    o = jnp.moveaxis(outs, 0, 1).reshape(b, s, d)
    return o @ w_out


def _stick_breaking_mixer(h, w_in, w_out):
    b, s, d = h.shape
    q, k, v = jnp.split(h @ w_in, 3, axis=-1)
    q = jnp.transpose(q.reshape(b, s, N_HEADS, HEAD_DIM), (0, 2, 1, 3)) * (HEAD_DIM ** -0.5)
    k = jnp.transpose(k.reshape(b, s, N_HEADS, HEAD_DIM), (0, 2, 1, 3))
    v = jnp.transpose(v.reshape(b, s, N_HEADS, HEAD_DIM), (0, 2, 1, 3))
    qb = SB_QBLOCK
    kpos = jnp.arange(s)

    def step(c):
        qs = c * qb
        qc = lax.dynamic_slice_in_dim(q, qs, qb, axis=2)
        t = qs + jnp.arange(qb)
        before = kpos[None] < t[:, None]
        z = jnp.einsum('bhqd,bhkd->bhqk', qc, k, preferred_element_type=jnp.float32)
        log_1m_beta = jnp.where(before, -jax.nn.softplus(z), 0.0)
        suffix = lax.cumsum(log_1m_beta, axis=3, reverse=True) - log_1m_beta
        log_a = -jax.nn.softplus(-z) + suffix
        a = jnp.where(before, jnp.exp(log_a), 0.0)
        return jnp.einsum('bhqk,bhkd->bqhd', a.astype(v.dtype), v)

    outs = lax.map(step, jnp.arange(s // qb))
    o = jnp.moveaxis(outs, 0, 1).reshape(b, s, d)
    return o @ w_out


def setup_inputs(seed: int = 0) -> dict:
    key = jax.random.key(seed)
    ks = jax.random.split(key, 16)

    def nrm(k, shape, scale):
        return jax.random.normal(k, shape, jnp.float32) * scale

    na, nb = N_NSA_LAYERS, N_SB_LAYERS
    return {
        "x": nrm(ks[0], (BATCH, SEQ, D_MODEL), 1.0),
        "mix_norm_g": 1.0 + nrm(ks[1], (DEPTH, D_MODEL), 0.05),
        "ffn_norm_g": 1.0 + nrm(ks[2], (DEPTH, D_MODEL), 0.05),
        "final_norm_g": 1.0 + nrm(ks[3], (D_MODEL,), 0.05),
        "nsa_w_in": nrm(ks[4], (na, D_MODEL, NSA_IN_W), D_MODEL ** -0.5),
        "nsa_gate_b": nrm(ks[5], (na, N_BRANCH * N_HEADS), 0.1),
        "nsa_cmp_pe": nrm(ks[6], (na, 2, CMP_BLOCK, HEAD_DIM), 0.1),
        "nsa_cmp_w1": nrm(ks[7], (na, 2, CMP_BLOCK * HEAD_DIM, CMP_HIDDEN), (CMP_BLOCK * HEAD_DIM) ** -0.5),
        "nsa_cmp_w2": nrm(ks[8], (na, 2, CMP_HIDDEN, HEAD_DIM), CMP_HIDDEN ** -0.5),
        "nsa_w_out": nrm(ks[9], (na, D_MODEL, D_MODEL), D_MODEL ** -0.5),
        "sb_w_in": nrm(ks[10], (nb, D_MODEL, 3 * D_MODEL), D_MODEL ** -0.5),
        "sb_w_out": nrm(ks[11], (nb, D_MODEL, D_MODEL), D_MODEL ** -0.5),
        "ffn_w1": nrm(ks[12], (DEPTH, D_MODEL, D_FF), D_MODEL ** -0.5),
        "ffn_w3": nrm(ks[13], (DEPTH, D_MODEL, D_FF), D_MODEL ** -0.5),
        "ffn_w2": nrm(ks[14], (DEPTH, D_FF, D_MODEL), D_FF ** -0.5),
    }


def reference(x, mix_norm_g, ffn_norm_g, final_norm_g, nsa_w_in, nsa_gate_b, nsa_cmp_pe,
              nsa_cmp_w1, nsa_cmp_w2, nsa_w_out, sb_w_in, sb_w_out, ffn_w1, ffn_w3, ffn_w2):
    slopes = _alibi_slopes(N_HEADS)
    h = x
    for i in range(DEPTH):
        a = _rmsnorm(h, mix_norm_g[i])
        j = i // N_MIXERS
        if i % N_MIXERS == 0:
            mix = _nsa_mixer(a, nsa_w_in[j], nsa_gate_b[j], nsa_cmp_pe[j], nsa_cmp_w1[j],
                             nsa_cmp_w2[j], nsa_w_out[j], slopes)
        else:
            mix = _stick_breaking_mixer(a, sb_w_in[j], sb_w_out[j])
        h = h + mix
        h = h + _swiglu(_rmsnorm(h, ffn_norm_g[i]), ffn_w1[i], ffn_w3[i], ffn_w2[i])
    return _rmsnorm(h, final_norm_g)
```

```cpp
#include <hip/hip_runtime.h>
#include <hip/hip_cooperative_groups.h>
#include <cstdio>
#include <cstdint>
#include <cmath>
namespace cg = cooperative_groups;
namespace pg8 {
#define PG8_LAS __attribute__((address_space(3)))
typedef unsigned short bf16_t;
typedef short bf16x8 __attribute__((ext_vector_type(8)));
typedef float f32x4 __attribute__((ext_vector_type(4)));
typedef unsigned u32x4 __attribute__((ext_vector_type(4)));
constexpr int BM = 256, BK = 64, HALF = 128, HTB = HALF * BK * 2  , STAGE_BYTES = 8 * HTB, NXCD = 8, WGM = 8;

__host__ __device__ __forceinline__ int lds_byte(int r, int c) { const int st = (r >> 4) * 2 + (c >> 5), rr = r & 15, cc = c & 31, ob = rr * 64 + cc * 2; return st * 1024 + (ob ^ (((ob >> 9) & 1) << 5)); }
__host__ __device__ __forceinline__ void stage_rc(int b, int& R, int& C) { const int st = b / 1024, sb = b % 1024, swz = sb ^ (((sb >> 9) & 1) << 5); R = (st >> 1) * 16 + swz / 64; C = (st & 1) * 32 + (swz % 64) / 2; }
__host__ __device__ __forceinline__ int perm32(int rho) { const int n = rho >> 4, i = rho & 15; return 8 * (i >> 2) + 4 * n + (i & 3); }

struct Unit { int pm, pn; };
struct Gemm { const bf16_t* A; const bf16_t* Bt; int M, N, K; };

struct StaticOrder {
    int nM, nN, nwg, G, c;
    __host__ __device__ void init(int M, int N, int G_, int c_) { nM = M / BM; nN = N / BM; nwg = nM * nN; G = G_; c = c_; }
    __host__ __device__ bool next(int i, Unit& u) const {
        const long L = (long)i * G + c; if (L >= nwg) return false;
        int wgid = (int)L; { const int q = nwg / NXCD, r = nwg % NXCD, xcd = wgid % NXCD, off = wgid / NXCD; wgid = (xcd < r ? xcd * (q + 1) : r * (q + 1) + (xcd - r) * q) + off; }
        const int nig = WGM * nN, gid = wgid / nig, fm = gid * WGM, gsz = (nM - fm) < WGM ? (nM - fm) : WGM;
        u.pm = fm + ((wgid % nig) % gsz); u.pn = (wgid % nig) / gsz; return true;
    }
    __device__ __forceinline__ void a_ready(const Unit&) const {}
    __device__ __forceinline__ void done(const Unit&) const {}
};

__device__ __forceinline__ unsigned cvt_pk_bf16(float lo, float hi) { unsigned r; asm volatile("v_cvt_pk_bf16_f32 %0, %1, %2" : "=v"(r) : "v"(lo), "v"(hi)); return r; }
typedef unsigned u32x4 __attribute__((ext_vector_type(4)));
typedef float f32x2 __attribute__((ext_vector_type(2)));
__device__ __forceinline__ float row_rstd(const float* ss, int row) {
    const f32x4* p = (const f32x4*)(ss + (size_t)row * 16);
    const f32x4 a = p[0], b = p[1], c = p[2], d = p[3];
    const float s = (((a[0] + a[1]) + (a[2] + a[3])) + ((b[0] + b[1]) + (b[2] + b[3]))) + (((c[0] + c[1]) + (c[2] + c[3])) + ((d[0] + d[1]) + (d[2] + d[3])));
    return rsqrtf(s * (1.0f / 1024.0f) + 1e-6f);
}
struct EpiProj {
    static constexpr bool PERM = true, AFTER_DRAIN = false;
    bf16_t* O; int ldc; const float* ss; const float* gate_b; float* gates; int gate_col0;
    __device__ __forceinline__ void operator()(const f32x4 (&acc)[2][2][4][2], const Unit& u, int wr, int wc, int fr, int fq) const {
        const int row0 = u.pm * BM + wr * 64 + fr, col0 = u.pn * BM + wc * 32 + 8 * fq;
#pragma unroll
        for (int ai = 0; ai < 2; ++ai)
#pragma unroll
            for (int m = 0; m < 4; ++m) {
                const int row = row0 + ai * HALF + m * 16; const float rs = row_rstd(ss, row);
#pragma unroll
                for (int bj = 0; bj < 2; ++bj) {
                    const int col = col0 + bj * HALF;
                    const f32x4 v0 = acc[ai][bj][m][0] * rs, v1 = acc[ai][bj][m][1] * rs;
                    if (col >= gate_col0) {
                        if (col < gate_col0 + 48) {
                            const int gc = col - gate_col0; const f32x4 b0 = *(const f32x4*)(gate_b + gc), b1 = *(const f32x4*)(gate_b + gc + 4);
                            f32x4 g0, g1;
#pragma unroll
                            for (int k = 0; k < 4; ++k) { g0[k] = 1.0f / (1.0f + __expf(-(v0[k] + b0[k]))); g1[k] = 1.0f / (1.0f + __expf(-(v1[k] + b1[k]))); }
                            *(f32x4*)(gates + (size_t)row * 48 + gc) = g0; *(f32x4*)(gates + (size_t)row * 48 + gc + 4) = g1;
                        }
                    } else {
                        u32x4 w; w.x = cvt_pk_bf16(v0[0], v0[1]); w.y = cvt_pk_bf16(v0[2], v0[3]); w.z = cvt_pk_bf16(v1[0], v1[1]); w.w = cvt_pk_bf16(v1[2], v1[3]);
                        *(u32x4*)(O + (size_t)row * ldc + col) = w;
                    }
                }
            }
    }
};
struct EpiResid {
    static constexpr bool PERM = true, AFTER_DRAIN = false;
    const float* base; float* out; bf16_t* hb; float* ss;
    __device__ __forceinline__ void operator()(const f32x4 (&acc)[2][2][4][2], const Unit& u, int wr, int wc, int fr, int fq) const {
        const int row0 = u.pm * BM + wr * 64 + fr, col0 = u.pn * BM + wc * 32 + 8 * fq;
#pragma unroll
        for (int ai = 0; ai < 2; ++ai)
#pragma unroll
            for (int m = 0; m < 4; ++m) {
                const int row = row0 + ai * HALF + m * 16; float sq = 0.f;
#pragma unroll
                for (int bj = 0; bj < 2; ++bj) {
                    const size_t off = (size_t)row * 1024 + col0 + bj * HALF;
                    const f32x4 v0 = *(const f32x4*)(base + off) + acc[ai][bj][m][0], v1 = *(const f32x4*)(base + off + 4) + acc[ai][bj][m][1];
                    *(f32x4*)(out + off) = v0; *(f32x4*)(out + off + 4) = v1;
                    u32x4 w; w.x = cvt_pk_bf16(v0[0], v0[1]); w.y = cvt_pk_bf16(v0[2], v0[3]); w.z = cvt_pk_bf16(v1[0], v1[1]); w.w = cvt_pk_bf16(v1[2], v1[3]);
                    *(u32x4*)(hb + off) = w;
                    sq += ((v0[0] * v0[0] + v0[1] * v0[1]) + (v0[2] * v0[2] + v0[3] * v0[3])) + ((v1[0] * v1[0] + v1[1] * v1[1]) + (v1[2] * v1[2] + v1[3] * v1[3]));
                }
                sq += __shfl_xor(sq, 16); sq += __shfl_xor(sq, 32);
                if (fq == 0) ss[(size_t)row * 16 + u.pn * 4 + wc] = sq;
            }
    }
};
struct EpiSwiGLU {
    static constexpr bool PERM = true, AFTER_DRAIN = false;
    bf16_t* O; const float* ss;
    __device__ __forceinline__ void operator()(const f32x4 (&acc)[2][2][4][2], const Unit& u, int wr, int wc, int fr, int fq) const {
        const int row0 = u.pm * BM + wr * 64 + fr, col = u.pn * HALF + wc * 32 + 8 * fq;
#pragma unroll
        for (int ai = 0; ai < 2; ++ai)
#pragma unroll
            for (int m = 0; m < 4; ++m) {
                const int row = row0 + ai * HALF + m * 16; const float rs = row_rstd(ss, row);
                float o[8];
#pragma unroll
                for (int n = 0; n < 2; ++n)
#pragma unroll
                    for (int k = 0; k < 4; ++k) { const float a = acc[ai][0][m][n][k] * rs, b = acc[ai][1][m][n][k] * rs; o[n * 4 + k] = a * b / (1.0f + __expf(-a)); }
                u32x4 w; w.x = cvt_pk_bf16(o[0], o[1]); w.y = cvt_pk_bf16(o[2], o[3]); w.z = cvt_pk_bf16(o[4], o[5]); w.w = cvt_pk_bf16(o[6], o[7]);
                *(u32x4*)(O + (size_t)row * 2816 + col) = w;
            }
    }
};
template <class Epi, class Sched, bool ALIGN_EPI = false, bool SP2 = false>
__device__ __forceinline__ void gemm_phase(PG8_LAS unsigned char* lds, const Gemm g, const Sched& S, const Epi& E) {
    int tid_ = threadIdx.x; asm volatile("" : "+v"(tid_)); const int tid = tid_, wid = __builtin_amdgcn_readfirstlane(tid >> 6), lane = tid & 63, wr = wid >> 2, wc = wid & 3, fr = lane & 15, fq = lane >> 4;
    const int K = g.K, nt = K / BK;
    unsigned voffA[2], voffB[2];
#pragma unroll
    for (int i = 0; i < 2; ++i) { int R, C; stage_rc(tid * 16 + i * 8192, R, C); const int Rb = Epi::PERM ? ((R & ~31) + perm32(R & 31)) : R;
        voffA[i] = (unsigned)(R * K + C) * 2u; voffB[i] = (unsigned)(Rb * K + C) * 2u; }
    const size_t kstep = (size_t)(BK * 2);
    const size_t hstep = (size_t)HALF * K * 2;
    const size_t tstep = 2 * hstep;
    const unsigned ldsw = (unsigned)wid * 1024u;
    const int aoff = lds_byte(wr * 64 + fr, fq * 8), boff = lds_byte(wc * 32 + fr, fq * 8);
#define PG8_SA(b, h) (((b) * 2 + (h)) * HTB)
#define PG8_SB(b, h) ((4 + (b) * 2 + (h)) * HTB)
#define PG8_STAGE(bufoff, gbase, voff) do { _Pragma("unroll") for (int _i = 0; _i < 2; ++_i) \
        __builtin_amdgcn_global_load_lds((const unsigned*)((const char*)(gbase) + (voff)[_i]), (PG8_LAS unsigned*)(lds + (bufoff) + ldsw + _i * 8192), 16, 0, 0); } while (0)
#define PG8_LDA(dst, b, h) do { _Pragma("unroll") for (int m = 0; m < 4; ++m) _Pragma("unroll") for (int k = 0; k < 2; ++k) dst[m][k] = *(const PG8_LAS bf16x8*)(lds + PG8_SA(b, h) + aoff + m * 2048 + k * 1024); } while (0)
#define PG8_LDB(dst, b, h) do { _Pragma("unroll") for (int n = 0; n < 2; ++n) _Pragma("unroll") for (int k = 0; k < 2; ++k) dst[n][k] = *(const PG8_LAS bf16x8*)(lds + PG8_SB(b, h) + boff + n * 2048 + k * 1024); } while (0)
#define PG8_MMA(ai, bj, At, Bt) do { __builtin_amdgcn_s_setprio(1); _Pragma("unroll") for (int m = 0; m < 4; ++m) _Pragma("unroll") for (int n = 0; n < 2; ++n) _Pragma("unroll") for (int k = 0; k < 2; ++k) \
        acc[ai][bj][m][n] = __builtin_amdgcn_mfma_f32_16x16x32_bf16(Bt[n][k], At[m][k], acc[ai][bj][m][n], 0, 0, 0); __builtin_amdgcn_s_setprio(0); } while (0)
#define PG8_WAIT_V(n) asm volatile("s_waitcnt vmcnt(" #n ")" ::: "memory")
#define PG8_WAIT_L(n) asm volatile("s_waitcnt lgkmcnt(" #n ")" ::: "memory")
#define PG8_BAR __builtin_amdgcn_s_barrier()
#define PG8_SCHED __builtin_amdgcn_sched_barrier(0)
    Unit cur, nxt; int ui = 0;
    if (!S.next(0, cur)) return;
    f32x4 acc[2][2][4][2];
#pragma unroll
    for (int a = 0; a < 2; ++a)
#pragma unroll
        for (int b = 0; b < 2; ++b)
#pragma unroll
            for (int m = 0; m < 4; ++m)
#pragma unroll
                for (int n = 0; n < 2; ++n) acc[a][b][m][n] = (f32x4){0.f, 0.f, 0.f, 0.f};
    bf16x8 At[4][2], B0[2][2], B1[2][2];
    const char* cA = (const char*)g.A + (size_t)cur.pm * tstep; const char* cB = (const char*)g.Bt + (size_t)cur.pn * tstep;
    S.a_ready(cur);
    if constexpr (SP2) {
        PG8_STAGE(PG8_SB(0, 0), cB, voffB); PG8_STAGE(PG8_SB(0, 1), cB + hstep, voffB); PG8_STAGE(PG8_SA(0, 0), cA, voffA); PG8_STAGE(PG8_SA(0, 1), cA + hstep, voffA);
        if (wr == 1) PG8_BAR;
        PG8_WAIT_V(2); PG8_BAR;
        PG8_STAGE(PG8_SB(1, 0), cB + kstep, voffB); PG8_STAGE(PG8_SA(1, 0), cA + kstep, voffA); PG8_STAGE(PG8_SB(1, 1), cB + hstep + kstep, voffB);
        PG8_WAIT_V(6); PG8_BAR;
    } else {
        PG8_STAGE(PG8_SB(0, 0), cB, voffB); PG8_STAGE(PG8_SA(0, 0), cA, voffA); PG8_STAGE(PG8_SB(0, 1), cB + hstep, voffB); PG8_STAGE(PG8_SA(0, 1), cA + hstep, voffA);
        if (wr == 1) PG8_BAR;
        PG8_WAIT_V(4); PG8_BAR;
        PG8_STAGE(PG8_SB(1, 0), cB + kstep, voffB); PG8_STAGE(PG8_SA(1, 0), cA + kstep, voffA); PG8_STAGE(PG8_SB(1, 1), cB + hstep + kstep, voffB);
        PG8_WAIT_V(6); PG8_BAR;
    }
    for (;;) {
        const bool has_next = S.next(ui + 1, nxt);
        const char* nA = has_next ? (const char*)g.A + (size_t)nxt.pm * tstep : cA; const char* nB = has_next ? (const char*)g.Bt + (size_t)nxt.pn * tstep : cB;
        for (int t = 0; t < nt; t += 2) {
            const bool last = (t == nt - 2);
            const char* a1 = cA + (size_t)(t + 1) * kstep;
            const char* a2 = last ? nA : cA + (size_t)(t + 2) * kstep; const char* b2 = last ? nB : cB + (size_t)(t + 2) * kstep;
            const char* a3 = a2 + kstep; const char* b3 = b2 + kstep;
            if (last && has_next) S.a_ready(nxt);
            if constexpr (SP2) {
            PG8_LDB(B0, 0, 0); PG8_LDB(B1, 0, 1); PG8_SCHED; PG8_LDA(At, 0, 0); PG8_STAGE(PG8_SA(1, 1), a1 + hstep, voffA);
            PG8_WAIT_V(8); PG8_WAIT_L(0); PG8_BAR; PG8_MMA(0, 0, At, B0); PG8_MMA(0, 1, At, B1); PG8_BAR; PG8_SCHED;
            PG8_LDA(At, 0, 1); PG8_STAGE(PG8_SB(0, 0), b2, voffB); PG8_STAGE(PG8_SB(0, 1), b2 + hstep, voffB); PG8_STAGE(PG8_SA(0, 0), a2, voffA);
            PG8_WAIT_V(8); PG8_WAIT_L(0); PG8_BAR; PG8_MMA(1, 0, At, B0); PG8_MMA(1, 1, At, B1); PG8_BAR; PG8_SCHED;
            PG8_LDB(B0, 1, 0); PG8_LDB(B1, 1, 1); PG8_SCHED; PG8_LDA(At, 1, 0); PG8_STAGE(PG8_SA(0, 1), a2 + hstep, voffA);
            PG8_WAIT_V(8); PG8_WAIT_L(0); PG8_BAR; PG8_MMA(0, 0, At, B0); PG8_MMA(0, 1, At, B1); PG8_BAR; PG8_SCHED;
            PG8_LDA(At, 1, 1); PG8_STAGE(PG8_SB(1, 0), b3, voffB); PG8_STAGE(PG8_SB(1, 1), b3 + hstep, voffB); PG8_STAGE(PG8_SA(1, 0), a3, voffA);
            PG8_WAIT_V(8); PG8_WAIT_L(0); PG8_BAR; PG8_MMA(1, 0, At, B0); PG8_MMA(1, 1, At, B1); PG8_BAR; PG8_SCHED;
            } else {
            PG8_LDB(B0, 0, 0); PG8_SCHED; PG8_LDA(At, 0, 0); PG8_STAGE(PG8_SA(1, 1), a1 + hstep, voffA);
            PG8_WAIT_L(8); PG8_BAR; PG8_WAIT_L(0); PG8_MMA(0, 0, At, B0); PG8_BAR; PG8_SCHED;
            PG8_LDB(B1, 0, 1); PG8_STAGE(PG8_SB(0, 0), b2, voffB);
            PG8_BAR; PG8_WAIT_L(0); PG8_MMA(0, 1, At, B1); PG8_BAR;
            PG8_LDA(At, 0, 1); PG8_STAGE(PG8_SA(0, 0), a2, voffA);
            PG8_BAR; PG8_WAIT_L(0); PG8_MMA(1, 0, At, B0); PG8_BAR; PG8_SCHED;
            PG8_STAGE(PG8_SB(0, 1), b2 + hstep, voffB);
            PG8_WAIT_V(6); PG8_BAR; PG8_MMA(1, 1, At, B1); PG8_BAR;
            PG8_LDB(B0, 1, 0); PG8_SCHED; PG8_LDA(At, 1, 0); PG8_STAGE(PG8_SA(0, 1), a2 + hstep, voffA);
            PG8_WAIT_L(8); PG8_BAR; PG8_WAIT_L(0); PG8_MMA(0, 0, At, B0); PG8_BAR; PG8_SCHED;
            PG8_LDB(B1, 1, 1); PG8_STAGE(PG8_SB(1, 0), b3, voffB);
            PG8_BAR; PG8_WAIT_L(0); PG8_MMA(0, 1, At, B1); PG8_BAR;
            PG8_LDA(At, 1, 1); PG8_STAGE(PG8_SA(1, 0), a3, voffA);
            PG8_BAR; PG8_WAIT_L(0); PG8_MMA(1, 0, At, B0); PG8_BAR; PG8_SCHED;
            PG8_STAGE(PG8_SB(1, 1), b3 + hstep, voffB);
            PG8_WAIT_V(6); PG8_BAR; PG8_MMA(1, 1, At, B1); PG8_BAR;
            }
        }
        if constexpr (ALIGN_EPI) { if (wr == 0) PG8_BAR; }
        if constexpr (!Epi::AFTER_DRAIN) { E(acc, cur, wr, wc, fr, fq); S.done(cur); }
        if (!has_next) break;
#pragma unroll
        for (int a = 0; a < 2; ++a)
#pragma unroll
            for (int b = 0; b < 2; ++b)
#pragma unroll
                for (int m = 0; m < 4; ++m)
#pragma unroll
                    for (int n = 0; n < 2; ++n) acc[a][b][m][n] = (f32x4){0.f, 0.f, 0.f, 0.f};
        cur = nxt; cA = nA; cB = nB; ++ui;
        if constexpr (ALIGN_EPI) { if (wr == 1) PG8_BAR; }
    }
    PG8_WAIT_V(0);
    if constexpr (!ALIGN_EPI) { if (wr == 0) PG8_BAR; }
    PG8_BAR;
    if constexpr (Epi::AFTER_DRAIN) { E.fused(acc, cur, wr, wc, fr, fq, lds, wid, lane); S.done(cur); }
#undef PG8_SA
#undef PG8_SB
#undef PG8_STAGE
#undef PG8_LDA
#undef PG8_LDB
#undef PG8_MMA
#undef PG8_WAIT_V
#undef PG8_WAIT_L
#undef PG8_BAR
#undef PG8_SCHED
}
}
#define LAS __attribute__((address_space(3)))
typedef unsigned short bf16;
typedef short bf16x8 __attribute__((ext_vector_type(8)));
typedef short s16x4 __attribute__((ext_vector_type(4)));
typedef float f32x4 __attribute__((ext_vector_type(4)));
typedef float f32x16 __attribute__((ext_vector_type(16)));
typedef unsigned u32x4 __attribute__((ext_vector_type(4)));
typedef unsigned u32x2 __attribute__((ext_vector_type(2)));
constexpr int NB = 16, SEQ = 2048, DM = 1024, MTOK = NB * SEQ, NH = 16, HD = 64, NG = 4;
constexpr int NSA_W = 2608, NSA_P = 2816, SB_P = 3072, DFF = 2816, DFF2 = 5632;
constexpr float LOG2E = 1.4426950408889634f, LN2 = 0.6931471805599453f;
constexpr size_t MiB = 1u << 20;
constexpr size_t WS_WNSA = 0, WS_WSB = 12 * MiB, WS_WOUT = 24 * MiB, WS_W13 = 32 * MiB, WS_W2 = 76 * MiB, WS_CW1 = 98 * MiB, WS_CW2 = 102 * MiB,
                 WS_CBIAS = 102 * MiB + 256 * 1024, WS_KC = 103 * MiB, WS_VCT = 104 * MiB, WS_SS = 105 * MiB, WS_GATES = 107 * MiB, WS_HB = 114 * MiB,
                 WS_O = 178 * MiB, WS_PROJ = 242 * MiB, WS_END = 436 * MiB;
constexpr int LDS_BYTES = 147456;

struct Params { const float* in[15]; float* out; unsigned char* ws; int ph_lo, ph_hi; };

__device__ __forceinline__ unsigned f2bf(float f) { unsigned u = __builtin_bit_cast(unsigned, f); return (u + 0x7fffu + ((u >> 16) & 1u)) >> 16; }
__device__ __forceinline__ unsigned pk2(float lo, float hi) { return pg8::cvt_pk_bf16(lo, hi); }
__device__ __forceinline__ float wave_sum(float v) {
#pragma unroll
    for (int o = 1; o < 64; o <<= 1) v += __shfl_xor(v, o);
    return v;
}
__device__ __forceinline__ float swap32(float v) { return __shfl_xor(v, 32); }
__device__ __forceinline__ int crow(int r, int hi) { return (r & 3) + 8 * (r >> 2) + 4 * hi; }
__device__ __forceinline__ bf16x8 pack8(float a0, float a1, float a2, float a3, float a4, float a5, float a6, float a7) {
    u32x4 w; w.x = pk2(a0, a1); w.y = pk2(a2, a3); w.z = pk2(a4, a5); w.w = pk2(a6, a7); return __builtin_bit_cast(bf16x8, w);
}
typedef short v4i16_t __attribute__((ext_vector_type(4)));
__device__ __forceinline__ s16x4 vtr(const LAS unsigned char* p) { return __builtin_bit_cast(s16x4, __builtin_amdgcn_ds_read_tr16_b64_v4i16((LAS v4i16_t*)p)); }
#define MFMA32(a, b, c) __builtin_amdgcn_mfma_f32_32x32x16_bf16((a), (b), (c), 0, 0, 0)
#define MFMA16(a, b, c) __builtin_amdgcn_mfma_f32_16x16x32_bf16((a), (b), (c), 0, 0, 0)
#define LDS_FENCE() asm volatile("s_waitcnt lgkmcnt(0)" ::: "memory")

struct TrDesc { const float* W; int K, N; bf16* WT; int ldt; const float* ks; float qscale; int qcols; int mode; };
__device__ __forceinline__ void transpose_item(const TrDesc& d, LAS float* scr, int item, int lane) {
    const int nblk = (d.N + 31) >> 5, kb = item / nblk, nb = item - kb * nblk, k0 = 64 * kb, n0 = 32 * nb;
    const int nn = n0 + (lane & 31);
#pragma unroll 8
    for (int i = 0; i < 32; ++i) {
        const int kk = 2 * i + (lane >> 5);
        float v = (nn < d.N) ? d.W[(size_t)(k0 + kk) * d.N + nn] : 0.f;
        if (d.ks) v *= d.ks[k0 + kk];
        scr[kk * 33 + (lane & 31)] = v;
    }
    LDS_FENCE();
    const int c = lane & 7;
#pragma unroll
    for (int j = 0; j < 4; ++j) {
        const int nl = (lane >> 3) + 8 * j, n = n0 + nl; const LAS float* s = scr + (8 * c) * 33 + nl;
        const float sc = (n < d.qcols) ? d.qscale : 1.0f;
        u32x4 o; o.x = pk2(s[0 * 33] * sc, s[1 * 33] * sc); o.y = pk2(s[2 * 33] * sc, s[3 * 33] * sc); o.z = pk2(s[4 * 33] * sc, s[5 * 33] * sc); o.w = pk2(s[6 * 33] * sc, s[7 * 33] * sc);
        const int row = d.mode == 0 ? n : (256 * (n >> 7) + (n & 127) + (d.mode == 2 ? 128 : 0));
        if (n < d.N) *(u32x4*)(d.WT + (size_t)row * d.ldt + k0 + 8 * c) = o;
    }
    LDS_FENCE();
}

__device__ __forceinline__ void prologue(const Params& p, LAS unsigned char* lds, int G) {
    int tid_ = threadIdx.x; asm volatile("" : "+v"(tid_)); const int tid = tid_, lane = tid & 63, wave = __builtin_amdgcn_readfirstlane(tid >> 6);
    LAS float* scr = (LAS float*)(lds + wave * 16384);
    const int gw = blockIdx.x * 8 + wave, NGW = G * 8;
    unsigned char* ws = p.ws;
    const float* mixg = p.in[1]; const float* ffng = p.in[2];
    { constexpr int IT = 16 * 82;
      for (int it = gw; it < 2 * IT; it += NGW) { const int j = it / IT, r = it - j * IT;
        TrDesc d{p.in[4] + (size_t)j * DM * NSA_W, DM, NSA_W, (bf16*)(ws + WS_WNSA) + (size_t)j * NSA_P * DM, DM, mixg + (2 * j) * DM, 0.125f * LOG2E, 1024, 0};
        transpose_item(d, scr, r, lane); } }
    { constexpr int IT = 16 * 96;
      for (int it = gw; it < 2 * IT; it += NGW) { const int j = it / IT, r = it - j * IT;
        TrDesc d{p.in[10] + (size_t)j * DM * SB_P, DM, SB_P, (bf16*)(ws + WS_WSB) + (size_t)j * SB_P * DM, DM, mixg + (2 * j + 1) * DM, 0.125f, 1024, 0};
        transpose_item(d, scr, r, lane); } }
    { constexpr int IT = 16 * 32;
      for (int it = gw; it < 4 * IT; it += NGW) { const int i = it / IT, r = it - i * IT;
        const float* W = ((i & 1) ? p.in[11] : p.in[9]) + (size_t)(i >> 1) * DM * DM;
        TrDesc d{W, DM, DM, (bf16*)(ws + WS_WOUT) + (size_t)i * DM * DM, DM, nullptr, 1.f, 0, 0};
        transpose_item(d, scr, r, lane); } }
    { constexpr int IT = 16 * 88;
      for (int it = gw; it < 8 * IT; it += NGW) { const int q = it / IT, r = it - q * IT, i = q & 3, which = q >> 2;
        TrDesc d{(which ? p.in[13] : p.in[12]) + (size_t)i * DM * DFF, DM, DFF, (bf16*)(ws + WS_W13) + (size_t)i * DFF2 * DM, DM, ffng + i * DM, 1.f, 0, which ? 2 : 1};
        transpose_item(d, scr, r, lane); } }
    { constexpr int IT = 44 * 32;
      for (int it = gw; it < 4 * IT; it += NGW) { const int i = it / IT, r = it - i * IT;
        TrDesc d{p.in[14] + (size_t)i * DFF * DM, DFF, DM, (bf16*)(ws + WS_W2) + (size_t)i * DM * DFF, DFF, nullptr, 1.f, 0, 0};
        transpose_item(d, scr, r, lane); } }
    { constexpr int IT = 32 * 8;
      for (int it = gw; it < 4 * IT; it += NGW) { const int q = it / IT, r = it - q * IT;
        TrDesc d{p.in[7] + (size_t)q * 2048 * 256, 2048, 256, (bf16*)(ws + WS_CW1) + (size_t)q * 256 * 2048, 2048, nullptr, 1.f, 0, 0};
        transpose_item(d, scr, r, lane); } }
    { constexpr int IT = 4 * 2;
      for (int it = gw; it < 4 * IT; it += NGW) { const int q = it / IT, r = it - q * IT;
        TrDesc d{p.in[8] + (size_t)q * 256 * 64, 256, 64, (bf16*)(ws + WS_CW2) + (size_t)q * 64 * 256, 256, nullptr, 1.f, 0, 0};
        transpose_item(d, scr, r, lane); } }
    { const float* x = p.in[0]; bf16* hb = (bf16*)(ws + WS_HB); float* ss = (float*)(ws + WS_SS);
      for (int m = gw; m < MTOK; m += NGW) {
        const f32x4* xr = (const f32x4*)(x + (size_t)m * DM) + lane; float s = 0.f; f32x4 v[4];
#pragma unroll
        for (int j = 0; j < 4; ++j) { v[j] = xr[64 * j]; s += (v[j][0] * v[j][0] + v[j][1] * v[j][1]) + (v[j][2] * v[j][2] + v[j][3] * v[j][3]); }
        s = wave_sum(s);
        u32x2* o8 = (u32x2*)(hb + (size_t)m * DM) + lane;
#pragma unroll
        for (int j = 0; j < 4; ++j) { u32x2 w; w.x = pk2(v[j][0], v[j][1]); w.y = pk2(v[j][2], v[j][3]); o8[64 * j] = w; }
        if (lane < 16) ss[(size_t)m * 16 + lane] = (lane == 0) ? s : 0.f;
      } }
    { float* part = (float*)(ws + WS_CBIAS);
      for (int t = gw; t < 4 * 32; t += NGW) { const int q = t >> 5, kc = t & 31;
        const float* pe = p.in[6] + (size_t)q * 2048 + kc * 64; const float* W = p.in[7] + (size_t)q * 2048 * 256 + (size_t)kc * 64 * 256;
        f32x4 a = {0.f, 0.f, 0.f, 0.f};
        for (int k = 0; k < 64; ++k) { const float e = pe[k]; const f32x4 w = *((const f32x4*)(W + (size_t)k * 256) + lane); a += w * e; }
        *((f32x4*)(part + (size_t)(q * 32 + kc) * 256) + lane) = a; } }
    { const int gt = blockIdx.x * 512 + tid, NT = G * 512; constexpr int PER = (NSA_P - NSA_W) * DM * 2 / 16;
      for (int i = gt; i < 2 * PER; i += NT) { const int j = i / PER, r = i - j * PER;
        *((u32x4*)((bf16*)(ws + WS_WNSA) + (size_t)j * NSA_P * DM + (size_t)NSA_W * DM) + r) = (u32x4){0u, 0u, 0u, 0u}; } }
}

__device__ __forceinline__ float gelu_tanh(float v) {
    const float u = 0.7978845608028654f * (v + 0.044715f * v * v * v);
    const float t = 1.0f - 2.0f / (1.0f + __expf(2.0f * u));
    return 0.5f * v * (1.0f + t);
}
__device__ __forceinline__ void compress_phase(const Params& p, LAS unsigned char* lds, int G, int layerj) {
    int tid_ = threadIdx.x; asm volatile("" : "+v"(tid_)); const int tid = tid_, lane = tid & 63, w = __builtin_amdgcn_readfirstlane(tid >> 6), l15 = lane & 15, l4 = lane >> 4;
    unsigned char* ws = p.ws;
    const bf16* proj = (const bf16*)(ws + WS_PROJ);
    LAS bf16* hid = (LAS bf16*)lds;
    for (int unit = blockIdx.x; unit < 256; unit += G) {
        const int kv = unit & 1, half = (unit >> 1) & 1, bg = unit >> 2, b = bg >> 2, g = bg & 3, n0 = half * 64;
        const int q = layerj * 2 + kv;
        const bf16* w1t = (const bf16*)(ws + WS_CW1) + (size_t)q * 256 * 2048;
        const bf16* w2t = (const bf16*)(ws + WS_CW2) + (size_t)q * 64 * 256;
        const float* part = (const float*)(ws + WS_CBIAS) + (size_t)q * 32 * 256;
        const int colbase = (kv ? 1280 : 1024) + g * 64;
        const bf16* abase = proj + (size_t)(b * SEQ + 16 * (n0 + l15)) * NSA_P + colbase + l4 * 8;
        const bf16* bbase = w1t + (size_t)(32 * w + l15) * 2048 + l4 * 8;
        f32x4 acc[4][2];
#pragma unroll
        for (int rb = 0; rb < 4; ++rb)
#pragma unroll
            for (int cb = 0; cb < 2; ++cb) acc[rb][cb] = (f32x4){0.f, 0.f, 0.f, 0.f};
#pragma unroll 2
        for (int l = 0; l < 32; ++l) {
#pragma unroll
            for (int ks = 0; ks < 2; ++ks) {
                bf16x8 a[4], bb[2];
#pragma unroll
                for (int rb = 0; rb < 4; ++rb) a[rb] = *(const bf16x8*)(abase + (size_t)(rb * 256 + l) * NSA_P + ks * 32);
#pragma unroll
                for (int cb = 0; cb < 2; ++cb) bb[cb] = *(const bf16x8*)(bbase + (size_t)cb * 16 * 2048 + l * 64 + ks * 32);
#pragma unroll
                for (int rb = 0; rb < 4; ++rb)
#pragma unroll
                    for (int cb = 0; cb < 2; ++cb) acc[rb][cb] = MFMA16(a[rb], bb[cb], acc[rb][cb]);
            }
        }
#pragma unroll
        for (int cb = 0; cb < 2; ++cb) {
            const int col = 32 * w + 16 * cb + l15; float bias = 0.f;
            for (int kc = 0; kc < 32; ++kc) bias += part[kc * 256 + col];
#pragma unroll
            for (int rb = 0; rb < 4; ++rb)
#pragma unroll
                for (int j = 0; j < 4; ++j) hid[(16 * rb + l4 * 4 + j) * 264 + col] = (bf16)f2bf(gelu_tanh(acc[rb][cb][j] + bias));
        }
        __syncthreads();
        const int rb2 = w >> 1;
        f32x4 o2[2] = {(f32x4){0.f, 0.f, 0.f, 0.f}, (f32x4){0.f, 0.f, 0.f, 0.f}};
#pragma unroll
        for (int ks = 0; ks < 8; ++ks) {
            const bf16x8 a = *(const LAS bf16x8*)(hid + (16 * rb2 + l15) * 264 + ks * 32 + l4 * 8);
#pragma unroll
            for (int c2 = 0; c2 < 2; ++c2) {
                const int cb = 2 * (w & 1) + c2;
                const bf16x8 bb = *(const bf16x8*)(w2t + (size_t)(16 * cb + l15) * 256 + ks * 32 + l4 * 8);
                o2[c2] = MFMA16(a, bb, o2[c2]);
            }
        }
#pragma unroll
        for (int c2 = 0; c2 < 2; ++c2) {
            const int d = 16 * (2 * (w & 1) + c2) + l15, nb = n0 + 16 * rb2 + l4 * 4;
            float v[4];
#pragma unroll
            for (int j = 0; j < 4; ++j) v[j] = (nb + j == 127) ? 0.f : o2[c2][j];
            if (kv == 0) {
                bf16* kc = (bf16*)(ws + WS_KC) + (size_t)((b * 4 + g) * 128) * 64;
#pragma unroll
                for (int j = 0; j < 4; ++j) kc[(size_t)(nb + j) * 64 + d] = (bf16)f2bf(v[j]);
            } else {
                bf16* vct = (bf16*)(ws + WS_VCT) + (size_t)((b * 4 + g) * 64 + d) * 128 + nb;
                u32x2 wv; wv.x = pk2(v[0], v[1]); wv.y = pk2(v[2], v[3]); *(u32x2*)vct = wv;
            }
        }
        __syncthreads();
    }
}
struct AttnState { float m, l; f32x16 o0, o1; };
constexpr int KV_BUF = 16384;
template <bool ELEM_MASK>
__device__ __forceinline__ void attn_tile(AttnState& st, const LAS unsigned char* qrl, const LAS unsigned char* kb, const LAS unsigned char* vb,
                                          float base, float slope2, int key0, int tq, int lo_q, int r32, int hi, int lane) {
    const LAS unsigned char* vp = vb + (4 * hi + ((lane & 15) >> 2)) * 64 + ((lane >> 4) & 1) * 32 + (lane & 3) * 8;
    const int rel = tq - key0 - 4 * hi, rello = lo_q - key0 - 4 * hi;
#pragma unroll
    for (int h = 0; h < 2; ++h) {
        f32x16 p0;
        const float hb = base + slope2 * (float)(4 * hi + 32 * h);
#pragma unroll
        for (int r = 0; r < 16; ++r) { const int cr = (r & 3) + 8 * (r >> 2); p0[r] = hb + slope2 * (float)cr; }
#pragma unroll
        for (int d0 = 0; d0 < 4; ++d0) {
            const bf16x8 k0 = *(const LAS bf16x8*)(kb + (2 * d0 + hi) * 1024 + h * 512 + r32 * 16);
            const bf16x8 qf = *(const LAS bf16x8*)(qrl + d0 * 1024);
            p0 = MFMA32(k0, qf, p0);
        }
        float mx = -INFINITY;
#pragma unroll
        for (int r = 0; r < 16; ++r) {
            if (ELEM_MASK) { const int cr = (r & 3) + 8 * (r >> 2) + 32 * h; p0[r] = (cr <= rel && cr >= rello) ? p0[r] : -INFINITY; }
            mx = fmaxf(mx, p0[r]);
        }
        mx = fmaxf(mx, swap32(mx));
        const float mnew = fmaxf(st.m, mx), alpha = __builtin_amdgcn_exp2f(st.m - mnew);
        st.m = mnew;
        float rs = 0.f;
#pragma unroll
        for (int r = 0; r < 16; ++r) { p0[r] = __builtin_amdgcn_exp2f(p0[r] - mnew); rs += p0[r]; }
        st.l = st.l * alpha + rs;
#pragma unroll
        for (int r = 0; r < 16; ++r) { st.o0[r] *= alpha; st.o1[r] *= alpha; }
        bf16x8 pb[2];
        pb[0] = pack8(p0[0], p0[1], p0[2], p0[3], p0[4], p0[5], p0[6], p0[7]);
        pb[1] = pack8(p0[8], p0[9], p0[10], p0[11], p0[12], p0[13], p0[14], p0[15]);
#pragma unroll
        for (int k2 = 0; k2 < 2; ++k2) {
            const int ks = 2 * h + k2;
            const s16x4 a0 = vtr(vp + ks * 1024), a1 = vtr(vp + ks * 1024 + 512), c0 = vtr(vp + 4096 + ks * 1024), c1 = vtr(vp + 4096 + ks * 1024 + 512);
            const bf16x8 v0 = __builtin_shufflevector(a0, a1, 0, 1, 2, 3, 4, 5, 6, 7);
            const bf16x8 v1 = __builtin_shufflevector(c0, c1, 0, 1, 2, 3, 4, 5, 6, 7);
            st.o0 = MFMA32(v0, pb[k2], st.o0); st.o1 = MFMA32(v1, pb[k2], st.o1);
        }
        if (h == 0) __builtin_amdgcn_sched_barrier(0);
    }
}

constexpr int IMP_OFF = 2 * KV_BUF, SELM_OFF = IMP_OFF + 4 * 64 * 33 * 4, OACC_OFF = SELM_OFF + 256;
__device__ __forceinline__ void nsa_branch(AttnState& st, const LAS unsigned char* qrl, LAS unsigned char* lds, unsigned tiles, const bf16* kbase, const bf16* vbase,
                                           unsigned mysel, float slope2, int tq, int lo_q, int qt, int lo_tile, int tid, int lane, int r32, int hi, int w) {
    asm volatile("" : "+v"(lane));
    r32 = lane & 31; hi = lane >> 5;
    qrl = lds + IMP_OFF + w * 4096 + lane * 16;
    const bf16* ksrc = kbase + (size_t)lane * NSA_P + w * 8;
    const bf16* vsrc = vbase + (size_t)(16 * (w & 3) + (lane >> 2)) * NSA_P + (w >> 2) * 32 + (lane & 3) * 8;
    const int sto = w * 1024 + lane * 16;
    unsigned rem = tiles;
    int j = __builtin_ctz(rem); rem &= rem - 1;
    u32x4 kreg = *(const u32x4*)(ksrc + (size_t)j * 64 * NSA_P), vreg = *(const u32x4*)(vsrc + (size_t)j * 64 * NSA_P);
    *(LAS u32x4*)(lds + sto) = kreg; *(LAS u32x4*)(lds + 8192 + sto) = vreg;
    __syncthreads();
    int buf = 0;
    for (;;) {
        const int jn = rem ? __builtin_ctz(rem) : -1;
        if (jn >= 0) { kreg = *(const u32x4*)(ksrc + (size_t)jn * 64 * NSA_P); vreg = *(const u32x4*)(vsrc + (size_t)jn * 64 * NSA_P); }
        const LAS unsigned char* kb = lds + buf * KV_BUF; const LAS unsigned char* vb = kb + 8192;
        const float base = ((mysel >> j) & 1u) ? slope2 * (float)(64 * j - tq) : -INFINITY;
        if (j == qt || j == lo_tile) attn_tile<true>(st, qrl, kb, vb, base, slope2, 64 * j, tq, lo_q, r32, hi, lane);
        else attn_tile<false>(st, qrl, kb, vb, base, slope2, 64 * j, tq, lo_q, r32, hi, lane);
        if (jn >= 0) { LAS unsigned char* nb = lds + (buf ^ 1) * KV_BUF; *(LAS u32x4*)(nb + sto) = kreg; *(LAS u32x4*)(nb + 8192 + sto) = vreg; }
        __syncthreads();
        if (jn < 0) break;
        rem &= rem - 1; j = jn; buf ^= 1;
    }
}

__device__ __forceinline__ void nsa_attn_phase(const Params& p, LAS unsigned char* lds, int G) {
    int tid_ = threadIdx.x; asm volatile("" : "+v"(tid_)); const int tid = tid_, lane = tid & 63, w = __builtin_amdgcn_readfirstlane(tid >> 6), r32 = lane & 31, hi = lane >> 5, hh = w & 3, tb = w >> 2;
    unsigned char* ws = p.ws;
    const bf16* proj = (const bf16*)(ws + WS_PROJ);
    const float* gates = (const float*)(ws + WS_GATES);
    bf16* obuf = (bf16*)(ws + WS_O);
    LAS float* impw = (LAS float*)(lds + IMP_OFF);
    LAS unsigned* selm = (LAS unsigned*)(lds + SELM_OFF);
    for (int u = blockIdx.x; u < 2048; u += G) {
        int bg, qt;
        if (G == 256) { const int r = u >> 8, k = u & 255, c = k >> 6; bg = k & 63; qt = (r & 1) ? 4 * r + 3 - c : 4 * r + c; }
        else { bg = u & 63; qt = u >> 6; }
        const int b = bg >> 2, g = bg & 3, head = 4 * g + hh;
        const float slope2 = __builtin_amdgcn_exp2f(-0.5f * (float)(head + 1)) * LOG2E;
        const int tq = 64 * qt + 32 * tb + r32; const size_t row = (size_t)b * SEQ + tq;
        bf16x8 qr[4];
        { const bf16* qp = proj + row * NSA_P + head * 64 + hi * 8;
#pragma unroll
          for (int d0 = 0; d0 < 4; ++d0) qr[d0] = *(const bf16x8*)(qp + d0 * 16); }
        LAS float* oacc = (LAS float*)(lds + OACC_OFF) + w * 2048 + lane;
        {
            const int nct = (4 * qt + 3 + 31) >> 5;
            const bf16* kcb = (const bf16*)(ws + WS_KC) + (size_t)((b * 4 + g) * 128) * 64;
            const bf16* vctb = (const bf16*)(ws + WS_VCT) + (size_t)((b * 4 + g) * 64) * 128;
            float m = -1e30f, l = 0.f;
#pragma unroll 1
            for (int t = 0; t < nct; ++t) {
                f32x16 a;
#pragma unroll
                for (int r = 0; r < 16; ++r) a[r] = 0.f;
#pragma unroll
                for (int d0 = 0; d0 < 4; ++d0) { const bf16x8 kf = *(const bf16x8*)(kcb + (size_t)(32 * t + r32) * 64 + d0 * 16 + hi * 8); a = MFMA32(kf, qr[d0], a); }
                float mx = -INFINITY;
#pragma unroll
                for (int r = 0; r < 16; ++r) { const int n = 32 * t + crow(r, hi), cend = 16 * n + 31; const float sv = a[r] + slope2 * (float)(cend - tq); a[r] = (cend <= tq) ? sv : -INFINITY; mx = fmaxf(mx, a[r]); }
                mx = fmaxf(mx, swap32(mx));
                const float mnew = fmaxf(m, mx); float rs = 0.f;
#pragma unroll
                for (int r = 0; r < 16; ++r) rs += __builtin_amdgcn_exp2f(a[r] - mnew);
                l = l * __builtin_amdgcn_exp2f(m - mnew) + rs; m = mnew;
            }
            l += swap32(l);
            const float inv = (l > 0.f) ? 1.0f / l : 0.f;
            LAS float* myimp = impw + (hh * 64 + tb * 32 + r32) * 33;
            float carry3 = 0.f;
            f32x16 out0, out1;
#pragma unroll
            for (int r = 0; r < 16; ++r) { out0[r] = 0.f; out1[r] = 0.f; }
#pragma unroll 1
            for (int t = 0; t < nct; ++t) {
                f32x16 a;
#pragma unroll
                for (int r = 0; r < 16; ++r) a[r] = 0.f;
#pragma unroll
                for (int d0 = 0; d0 < 4; ++d0) { const bf16x8 kf = *(const bf16x8*)(kcb + (size_t)(32 * t + r32) * 64 + d0 * 16 + hi * 8); a = MFMA32(kf, qr[d0], a); }
#pragma unroll
                for (int r = 0; r < 16; ++r) { const int n = 32 * t + crow(r, hi), cend = 16 * n + 31; const float sv = a[r] + slope2 * (float)(cend - tq); a[r] = (cend <= tq) ? __builtin_amdgcn_exp2f(sv - m) * inv : 0.f; }
                float rcv[4];
#pragma unroll
                for (int i = 0; i < 4; ++i) rcv[i] = swap32(a[4 * i + 3]);
#pragma unroll
                for (int i = 0; i < 4; ++i) {
                    const float own = 2.0f * (a[4 * i] + a[4 * i + 1] + a[4 * i + 2]) + a[4 * i + 3];
                    const float prev = hi ? rcv[i] : (i == 0 ? carry3 : rcv[i - 1]);
                    myimp[8 * t + 2 * i + hi] = own + prev;
                }
                carry3 = rcv[3];
#pragma unroll
                for (int ks = 0; ks < 2; ++ks) {
                    const bf16x8 pbk = pack8(a[8 * ks], a[8 * ks + 1], a[8 * ks + 2], a[8 * ks + 3], a[8 * ks + 4], a[8 * ks + 5], a[8 * ks + 6], a[8 * ks + 7]);
                    const bf16* v0p = vctb + (size_t)r32 * 128 + 32 * t + 16 * ks + 4 * hi;
                    const s16x4 a0 = *(const s16x4*)v0p, a1 = *(const s16x4*)(v0p + 8), c0 = *(const s16x4*)(v0p + 32 * 128), c1 = *(const s16x4*)(v0p + 32 * 128 + 8);
                    const bf16x8 v0 = __builtin_shufflevector(a0, a1, 0, 1, 2, 3, 4, 5, 6, 7);
                    const bf16x8 v1 = __builtin_shufflevector(c0, c1, 0, 1, 2, 3, 4, 5, 6, 7);
                    out0 = MFMA32(v0, pbk, out0); out1 = MFMA32(v1, pbk, out1);
                }
            }
            const float gc = gates[row * 48 + head];
#pragma unroll
            for (int r = 0; r < 16; ++r) { oacc[r * 64] = out0[r] * gc; oacc[(16 + r) * 64] = out1[r] * gc; }
        }
        __syncthreads();
        for (int idx = tid; idx < 64 * 32; idx += 512) { const int q = idx >> 5, jj = idx & 31; LAS float* a = impw + q * 33 + jj;
            a[0] = (a[0] + a[64 * 33]) + (a[2 * 64 * 33] + a[3 * 64 * 33]); }
        __syncthreads();
        if (qt + 1 <= 8) { if (tid < 64) selm[tid] = (1u << (qt + 1)) - 1u; }
        else {
#pragma unroll 1
            for (int it = 0; it < 4; ++it) {
                const int q = 8 * w + 2 * it + hi, jj = r32;
                const LAS float* rowp = impw + q * 33;
                const float my = rowp[jj]; int cnt = 0;
                for (int j2 = 1; j2 <= qt - 2; ++j2) { const float v = rowp[j2]; cnt += (v > my || (v == my && j2 < jj)) ? 1 : 0; }
                const bool forced = (jj == 0) || (jj == qt) || (jj == qt - 1);
                const bool cand = (jj >= 1) && (jj <= qt - 2);
                const bool sel = forced || (cand && cnt < 5);
                const unsigned long long bal = __ballot(sel);
                if (r32 == 0) selm[q] = hi ? (unsigned)(bal >> 32) : (unsigned)bal;
            }
        }
        __syncthreads();
        const unsigned mysel = selm[tb * 32 + r32];
        unsigned uni = selm[lane];
#pragma unroll
        for (int o = 1; o < 64; o <<= 1) uni |= __shfl_xor(uni, o);
        uni = __builtin_amdgcn_readfirstlane(uni);
        LAS unsigned char* qrl = lds + IMP_OFF + w * 4096 + lane * 16;
#pragma unroll
        for (int d0 = 0; d0 < 4; ++d0) *(LAS bf16x8*)(qrl + d0 * 1024) = qr[d0];
        {
            AttnState st; st.m = -1e30f; st.l = 0.f;
#pragma unroll
            for (int r = 0; r < 16; ++r) { st.o0[r] = 0.f; st.o1[r] = 0.f; }
            nsa_branch(st, qrl, lds, uni, proj + (size_t)b * SEQ * NSA_P + 1536 + g * 64, proj + (size_t)b * SEQ * NSA_P + 1792 + g * 64,
                       mysel, slope2, tq, -(1 << 30), qt, -1, tid, lane, r32, hi, w);
            int l2 = lane; asm volatile("" : "+v"(l2)); const size_t row2 = (size_t)b * SEQ + 64 * qt + 32 * tb + (l2 & 31); LAS float* oacc2 = (LAS float*)(lds + OACC_OFF) + w * 2048 + l2;
            const float lt = st.l + swap32(st.l); const float sc = gates[row2 * 48 + 16 + head] / lt;
#pragma unroll
            for (int r = 0; r < 16; ++r) { oacc2[r * 64] += st.o0[r] * sc; oacc2[(16 + r) * 64] += st.o1[r] * sc; }
        }
        {
            AttnState st; st.m = -1e30f; st.l = 0.f;
#pragma unroll
            for (int r = 0; r < 16; ++r) { st.o0[r] = 0.f; st.o1[r] = 0.f; }
            const int jlo = qt >= 8 ? qt - 8 : 0;
            const unsigned tiles = (unsigned)(((1ull << (qt + 1)) - 1ull) & ~((1ull << jlo) - 1ull));
            nsa_branch(st, qrl, lds, tiles, proj + (size_t)b * SEQ * NSA_P + 2048 + g * 64, proj + (size_t)b * SEQ * NSA_P + 2304 + g * 64,
                       0xffffffffu, slope2, tq, tq - 511, qt, qt - 8, tid, lane, r32, hi, w);
            int l2 = lane; asm volatile("" : "+v"(l2)); const size_t row2 = (size_t)b * SEQ + 64 * qt + 32 * tb + (l2 & 31); LAS float* oacc2 = (LAS float*)(lds + OACC_OFF) + w * 2048 + l2;
            const float lt = st.l + swap32(st.l); const float sc = gates[row2 * 48 + 32 + head] / lt;
            f32x16 out0, out1;
#pragma unroll
            for (int r = 0; r < 16; ++r) { out0[r] = oacc2[r * 64] + st.o0[r] * sc; out1[r] = oacc2[(16 + r) * 64] + st.o1[r] * sc; }
          bf16* op = obuf + row2 * DM + head * 64 + 4 * (l2 >> 5);
#pragma unroll
          for (int i = 0; i < 4; ++i) {
            u32x2 w0; w0.x = pk2(out0[4 * i], out0[4 * i + 1]); w0.y = pk2(out0[4 * i + 2], out0[4 * i + 3]); *(u32x2*)(op + 8 * i) = w0;
            u32x2 w1; w1.x = pk2(out1[4 * i], out1[4 * i + 1]); w1.y = pk2(out1[4 * i + 2], out1[4 * i + 3]); *(u32x2*)(op + 32 + 8 * i) = w1; } }
    }
}
__device__ __forceinline__ void sb_attn_phase(const Params& p, LAS unsigned char* lds, int G) {
    int tid_ = threadIdx.x; asm volatile("" : "+v"(tid_)); const int tid = tid_, lane = tid & 63, w = __builtin_amdgcn_readfirstlane(tid >> 6), r32 = lane & 31, hi = lane >> 5;
    unsigned char* ws = p.ws;
    const bf16* proj = (const bf16*)(ws + WS_PROJ);
    bf16* obuf = (bf16*)(ws + WS_O);
    LAS unsigned char* vl = lds + w * 4096;
    const LAS unsigned char* vp = vl + (4 * hi + ((lane & 15) >> 2)) * 64 + ((lane >> 4) & 1) * 32 + (lane & 3) * 8;
    const int gw = blockIdx.x * 8 + w, NGW = G * 8;
    for (int u = gw; u < NB * NH * 64; u += NGW) {
        const int qb = u & 63, head = (u >> 6) & 15, b = u >> 10;
        const int tq = 32 * qb + r32; const size_t row = (size_t)b * SEQ + tq;
        bf16x8 qr[4];
        { const bf16* qp = proj + row * SB_P + head * 64 + hi * 8;
#pragma unroll
          for (int d0 = 0; d0 < 4; ++d0) qr[d0] = *(const bf16x8*)(qp + d0 * 16); }
        const bf16* kbase = proj + (size_t)b * SEQ * SB_P + 1024 + head * 64;
        const bf16* vbase = proj + (size_t)b * SEQ * SB_P + 2048 + head * 64;
        f32x16 o0, o1;
#pragma unroll
        for (int r = 0; r < 16; ++r) { o0[r] = 0.f; o1[r] = 0.f; }
        float carry = 0.f;
        for (int kt = qb; kt >= 0; --kt) {
            const int key0 = 32 * kt;
            u32x4 vreg[4];
#pragma unroll
            for (int i = 0; i < 4; ++i) { const int idx = i * 64 + lane, db = idx >> 7, key = (idx >> 2) & 31, c4 = idx & 3;
                vreg[i] = *(const u32x4*)(vbase + (size_t)(key0 + key) * SB_P + 32 * db + 8 * c4); }
            f32x16 z;
#pragma unroll
            for (int r = 0; r < 16; ++r) z[r] = 0.f;
#pragma unroll
            for (int d0 = 0; d0 < 4; ++d0) { const bf16x8 kf = *(const bf16x8*)(kbase + (size_t)(key0 + r32) * SB_P + d0 * 16 + hi * 8); z = MFMA32(kf, qr[d0], z); }
            LDS_FENCE();
#pragma unroll
            for (int i = 0; i < 4; ++i) *(LAS u32x4*)(vl + (i * 64 + lane) * 16) = vreg[i];
            float L[16]; bool bef[16];
#pragma unroll
            for (int r = 0; r < 16; ++r) {
                const float zz = z[r];
                const float e = __builtin_amdgcn_exp2f(-fabsf(zz) * LOG2E);
                const float sp = fmaxf(zz, 0.f) + __builtin_amdgcn_logf(1.0f + e) * LN2;
                bef[r] = (key0 + crow(r, hi)) < tq;
                L[r] = bef[r] ? -sp : 0.f;
            }
            float gsum[4], og[4], T[4];
#pragma unroll
            for (int i = 0; i < 4; ++i) { gsum[i] = (L[4 * i] + L[4 * i + 1]) + (L[4 * i + 2] + L[4 * i + 3]); og[i] = swap32(gsum[i]); T[i] = gsum[i] + og[i]; }
            float R[4]; R[3] = 0.f; R[2] = T[3]; R[1] = T[3] + T[2]; R[0] = R[1] + T[1];
            float a[16];
#pragma unroll
            for (int i = 0; i < 4; ++i) {
                const float A = carry + R[i] + (hi ? 0.f : og[i]);
                const float s3 = A, s2 = s3 + L[4 * i + 3], s1 = s2 + L[4 * i + 2], s0 = s1 + L[4 * i + 1];
                const float suf[4] = {s0, s1, s2, s3};
#pragma unroll
                for (int e4 = 0; e4 < 4; ++e4) { const int r = 4 * i + e4; const float la = z[r] + L[r] + suf[e4]; a[r] = bef[r] ? __builtin_amdgcn_exp2f(la * LOG2E) : 0.f; }
            }
            carry += R[0] + T[0];
            const bf16x8 pb0 = pack8(a[0], a[1], a[2], a[3], a[4], a[5], a[6], a[7]), pb1 = pack8(a[8], a[9], a[10], a[11], a[12], a[13], a[14], a[15]);
            LDS_FENCE();
#pragma unroll
            for (int ks = 0; ks < 2; ++ks) {
                const s16x4 a0 = vtr(vp + ks * 1024), a1 = vtr(vp + ks * 1024 + 512), c0 = vtr(vp + 2048 + ks * 1024), c1 = vtr(vp + 2048 + ks * 1024 + 512);
                const bf16x8 v0 = __builtin_shufflevector(a0, a1, 0, 1, 2, 3, 4, 5, 6, 7);
                const bf16x8 v1 = __builtin_shufflevector(c0, c1, 0, 1, 2, 3, 4, 5, 6, 7);
                o0 = MFMA32(v0, ks ? pb1 : pb0, o0); o1 = MFMA32(v1, ks ? pb1 : pb0, o1);
            }
            if (__all(carry < -100.0f)) break;
        }
        LDS_FENCE();
        { bf16* op = obuf + row * DM + head * 64 + 4 * hi;
#pragma unroll
          for (int i = 0; i < 4; ++i) {
            u32x2 w0; w0.x = pk2(o0[4 * i], o0[4 * i + 1]); w0.y = pk2(o0[4 * i + 2], o0[4 * i + 3]); *(u32x2*)(op + 8 * i) = w0;
            u32x2 w1; w1.x = pk2(o1[4 * i], o1[4 * i + 1]); w1.y = pk2(o1[4 * i + 2], o1[4 * i + 3]); *(u32x2*)(op + 32 + 8 * i) = w1; } }
    }
}

__device__ __forceinline__ void final_norm_phase(const Params& p, int G) {
    int tid_ = threadIdx.x; asm volatile("" : "+v"(tid_));
    const int lane = tid_ & 63, gw = blockIdx.x * 8 + __builtin_amdgcn_readfirstlane(tid_ >> 6), NGW = G * 8;
    const float* ss = (const float*)(p.ws + WS_SS); const float* g = p.in[3];
    f32x4 gv[4];
#pragma unroll
    for (int j = 0; j < 4; ++j) gv[j] = *((const f32x4*)g + lane + 64 * j);
    for (int m = gw; m < MTOK; m += NGW) {
        const float rs = pg8::row_rstd(ss, m);
        f32x4* xr = (f32x4*)(p.out + (size_t)m * DM) + lane;
#pragma unroll
        for (int j = 0; j < 4; ++j) { const f32x4 v = xr[64 * j]; xr[64 * j] = v * rs * gv[j]; }
    }
}

__global__ void __launch_bounds__(512, 2) mega(Params p) {
    extern __shared__ __attribute__((aligned(16))) unsigned char lds_raw[];
    LAS unsigned char* lds = (LAS unsigned char*)lds_raw;
    cg::grid_group grid = cg::this_grid();
    const int G = gridDim.x;
    unsigned char* ws = p.ws;
    bf16* hb = (bf16*)(ws + WS_HB); bf16* proj = (bf16*)(ws + WS_PROJ); bf16* obuf = (bf16*)(ws + WS_O);
    float* ss = (float*)(ws + WS_SS); float* gates = (float*)(ws + WS_GATES);
    int ph = 0;
#define PHASE_ON (ph >= p.ph_lo && ph < p.ph_hi)
#define PHASE_END do { if (ph >= p.ph_lo && ph + 1 < p.ph_hi) grid.sync(); ++ph; } while (0)
    if (PHASE_ON) prologue(p, lds, G);
    PHASE_END;
#pragma unroll 1
    for (int i = 0; i < 4; ++i) {
        const bool nsa = !(i & 1); const int j = i >> 1;
        if (PHASE_ON) {
            const bf16* Wt = nsa ? (const bf16*)(ws + WS_WNSA) + (size_t)j * NSA_P * DM : (const bf16*)(ws + WS_WSB) + (size_t)j * SB_P * DM;
            const int N = nsa ? NSA_P : SB_P;
            pg8::Gemm g{hb, Wt, MTOK, N, DM}; pg8::StaticOrder S; S.init(MTOK, N, G, (int)blockIdx.x);
            pg8::EpiProj E{proj, N, ss, p.in[5] + j * 48, gates, nsa ? 2560 : (1 << 30)};
            pg8::gemm_phase<pg8::EpiProj, pg8::StaticOrder, true, true>(lds, g, S, E);
        }
        PHASE_END;
        if (nsa) {
            if (PHASE_ON) compress_phase(p, lds, G, j);
            PHASE_END;
            if (PHASE_ON) nsa_attn_phase(p, lds, G);
            PHASE_END;
        } else {
            if (PHASE_ON) sb_attn_phase(p, lds, G);
            PHASE_END;
        }
#pragma unroll 1
        for (int s = 0; s < 2; ++s) {
            if (PHASE_ON) {
                const bf16* A = s == 0 ? obuf : proj;
                const bf16* Wt = s == 0 ? (const bf16*)(ws + WS_WOUT) + (size_t)i * DM * DM : (const bf16*)(ws + WS_W2) + (size_t)i * DM * DFF;
                pg8::Gemm g{A, Wt, MTOK, DM, s == 0 ? DM : DFF}; pg8::StaticOrder S; S.init(MTOK, DM, G, (int)blockIdx.x);
                pg8::EpiResid E{(i == 0 && s == 0) ? p.in[0] : p.out, p.out, hb, ss};
                pg8::gemm_phase<pg8::EpiResid, pg8::StaticOrder, true, true>(lds, g, S, E);
            }
            PHASE_END;
            if (s == 0) {
                if (PHASE_ON) {
                    pg8::Gemm g{hb, (const bf16*)(ws + WS_W13) + (size_t)i * DFF2 * DM, MTOK, DFF2, DM}; pg8::StaticOrder S; S.init(MTOK, DFF2, G, (int)blockIdx.x);
                    pg8::EpiSwiGLU E{proj, ss};
                    pg8::gemm_phase<pg8::EpiSwiGLU, pg8::StaticOrder, true, true>(lds, g, S, E);
                }
                PHASE_END;
            }
        }
    }
    if (PHASE_ON) final_norm_phase(p, G);
}

extern "C" void kernel_launch(void* const* d_in, const int* in_sizes, int n_in, void* d_out, int out_size, void* d_ws, size_t ws_size, hipStream_t stream) {
    static int grid = 0;
    if (grid == 0) {
        if (n_in != 15 || out_size != MTOK * DM || ws_size < WS_END) { fprintf(stderr, "kernel_launch: unexpected shapes (n_in %d out %d ws %zu)\n", n_in, out_size, ws_size); grid = -1; return; }
        int dev = 0, cus = 0, per_cu = 0;
        if (hipGetDevice(&dev) != hipSuccess || hipDeviceGetAttribute(&cus, hipDeviceAttributeMultiprocessorCount, dev) != hipSuccess) { grid = -1; return; }
        if (hipFuncSetAttribute((const void*)mega, hipFuncAttributeMaxDynamicSharedMemorySize, LDS_BYTES) != hipSuccess) { fprintf(stderr, "hipFuncSetAttribute failed\n"); grid = -1; return; }
        if (hipOccupancyMaxActiveBlocksPerMultiprocessor(&per_cu, mega, 512, LDS_BYTES) != hipSuccess || per_cu < 1) { fprintf(stderr, "occupancy query failed\n"); grid = -1; return; }
        grid = cus;
    }
    if (grid <= 0) return;
    Params p{};
    for (int i = 0; i < 15; ++i) p.in[i] = (const float*)d_in[i];
    p.out = (float*)d_out; p.ws = (unsigned char*)d_ws; p.ph_lo = 0; p.ph_hi = 1000;
    void* args[] = {&p};
    hipError_t e = hipLaunchCooperativeKernel((void*)mega, dim3(grid), dim3(512), args, LDS_BYTES, stream);
    if (e != hipSuccess) fprintf(stderr, "cooperative launch failed: %s (grid %d)\n", hipGetErrorString(e), grid);
}
```

```cpp
#include <hip/hip_runtime.h>
#include <hip/hip_cooperative_groups.h>
#include <cstdio>
#include <cstdint>
#include <cmath>
namespace cg = cooperative_groups;
namespace pg8 {
#define PG8_LAS __attribute__((address_space(3)))
typedef unsigned short bf16_t;
typedef short bf16x8 __attribute__((ext_vector_type(8)));
typedef float f32x4 __attribute__((ext_vector_type(4)));
typedef unsigned u32x4 __attribute__((ext_vector_type(4)));
constexpr int BM = 256, BK = 64, HALF = 128, HTB = HALF * BK * 2  , STAGE_BYTES = 8 * HTB, NXCD = 8, WGM = 8;

__host__ __device__ __forceinline__ int lds_byte(int r, int c) { const int st = (r >> 4) * 2 + (c >> 5), rr = r & 15, cc = c & 31, ob = rr * 64 + cc * 2; return st * 1024 + (ob ^ (((ob >> 9) & 1) << 5)); }
__host__ __device__ __forceinline__ void stage_rc(int b, int& R, int& C) { const int st = b / 1024, sb = b % 1024, swz = sb ^ (((sb >> 9) & 1) << 5); R = (st >> 1) * 16 + swz / 64; C = (st & 1) * 32 + (swz % 64) / 2; }
__host__ __device__ __forceinline__ int perm32(int rho) { const int n = rho >> 4, i = rho & 15; return 8 * (i >> 2) + 4 * n + (i & 3); }

struct Unit { int pm, pn; };
struct Gemm { const bf16_t* A; const bf16_t* Bt; int M, N, K; };

struct StaticOrder {
    int nM, nN, nwg, G, c;
    __host__ __device__ void init(int M, int N, int G_, int c_) { nM = M / BM; nN = N / BM; nwg = nM * nN; G = G_; c = c_; }
    __host__ __device__ bool next(int i, Unit& u) const {
        const long L = (long)i * G + c; if (L >= nwg) return false;
        int wgid = (int)L; { const int q = nwg / NXCD, r = nwg % NXCD, xcd = wgid % NXCD, off = wgid / NXCD; wgid = (xcd < r ? xcd * (q + 1) : r * (q + 1) + (xcd - r) * q) + off; }
        const int nig = WGM * nN, gid = wgid / nig, fm = gid * WGM, gsz = (nM - fm) < WGM ? (nM - fm) : WGM;
        u.pm = fm + ((wgid % nig) % gsz); u.pn = (wgid % nig) / gsz; return true;
    }
    __device__ __forceinline__ void a_ready(const Unit&) const {}
    __device__ __forceinline__ void done(const Unit&) const {}
};

__device__ __forceinline__ unsigned cvt_pk_bf16(float lo, float hi) { unsigned r; asm volatile("v_cvt_pk_bf16_f32 %0, %1, %2" : "=v"(r) : "v"(lo), "v"(hi)); return r; }
typedef unsigned u32x4 __attribute__((ext_vector_type(4)));
typedef float f32x2 __attribute__((ext_vector_type(2)));
__device__ __forceinline__ float row_rstd(const float* ss, int row) {
    const f32x4* p = (const f32x4*)(ss + (size_t)row * 16);
    const f32x4 a = p[0], b = p[1], c = p[2], d = p[3];
    const float s = (((a[0] + a[1]) + (a[2] + a[3])) + ((b[0] + b[1]) + (b[2] + b[3]))) + (((c[0] + c[1]) + (c[2] + c[3])) + ((d[0] + d[1]) + (d[2] + d[3])));
    return rsqrtf(s * (1.0f / 1024.0f) + 1e-6f);
}
__device__ __forceinline__ void rows_rstd8(const float* ss, int row0, int fq, float (&rs)[2][4]) {
    f32x4 v[2][4];
#pragma unroll
    for (int ai = 0; ai < 2; ++ai)
#pragma unroll
        for (int m = 0; m < 4; ++m) v[ai][m] = *(const f32x4*)(ss + (size_t)(row0 + ai * HALF + m * 16) * 16 + 4 * fq);
#pragma unroll
    for (int ai = 0; ai < 2; ++ai)
#pragma unroll
        for (int m = 0; m < 4; ++m) { float t = (v[ai][m][0] + v[ai][m][1]) + (v[ai][m][2] + v[ai][m][3]); t += __shfl_xor(t, 16); t += __shfl_xor(t, 32); rs[ai][m] = rsqrtf(t * (1.0f / 1024.0f) + 1e-6f); }
}
struct EpiProj {
    static constexpr bool PERM = true, AFTER_DRAIN = false;
    bf16_t* O; int ldc; const float* ss; const float* gate_b; float* gates; int gate_col0;
    __device__ __forceinline__ void operator()(const f32x4 (&acc)[2][2][4][2], const Unit& u, int wr, int wc, int fr, int fq) const {
        const int row0 = u.pm * BM + wr * 64 + fr, col0 = u.pn * BM + wc * 32 + 8 * fq;
        float rsv[2][4]; rows_rstd8(ss, row0, fq, rsv);
#pragma unroll
        for (int ai = 0; ai < 2; ++ai)
#pragma unroll
            for (int m = 0; m < 4; ++m) {
                const int row = row0 + ai * HALF + m * 16; const float rs = rsv[ai][m];
#pragma unroll
                for (int bj = 0; bj < 2; ++bj) {
                    const int col = col0 + bj * HALF;
                    const f32x4 v0 = acc[ai][bj][m][0] * rs, v1 = acc[ai][bj][m][1] * rs;
                    if (col >= gate_col0) {
                        if (col < gate_col0 + 48) {
                            const int gc = col - gate_col0; const f32x4 b0 = *(const f32x4*)(gate_b + gc), b1 = *(const f32x4*)(gate_b + gc + 4);
                            f32x4 g0, g1;
#pragma unroll
                            for (int k = 0; k < 4; ++k) { g0[k] = 1.0f / (1.0f + __expf(-(v0[k] + b0[k]))); g1[k] = 1.0f / (1.0f + __expf(-(v1[k] + b1[k]))); }
                            *(f32x4*)(gates + (size_t)row * 48 + gc) = g0; *(f32x4*)(gates + (size_t)row * 48 + gc + 4) = g1;
                        }
                    } else {
                        u32x4 w; w.x = cvt_pk_bf16(v0[0], v0[1]); w.y = cvt_pk_bf16(v0[2], v0[3]); w.z = cvt_pk_bf16(v1[0], v1[1]); w.w = cvt_pk_bf16(v1[2], v1[3]);
                        *(u32x4*)(O + (size_t)row * ldc + col) = w;
                    }
                }
            }
    }
};
struct EpiResid {
    static constexpr bool PERM = true, AFTER_DRAIN = false;
    bf16_t* hb; float* ss;
    __device__ __forceinline__ void operator()(const f32x4 (&acc)[2][2][4][2], const Unit& u, int wr, int wc, int fr, int fq) const {
        const int row0 = u.pm * BM + wr * 64 + fr, col0 = u.pn * BM + wc * 32 + 8 * fq;
        u32x4 bq[2][4][2];
#pragma unroll
        for (int ai = 0; ai < 2; ++ai)
#pragma unroll
            for (int m = 0; m < 4; ++m)
#pragma unroll
                for (int bj = 0; bj < 2; ++bj) if (ai == 0 || m < 2) bq[ai][m][bj] = *(const u32x4*)(hb + (size_t)(row0 + ai * HALF + m * 16) * 1024 + col0 + bj * HALF);
#pragma unroll
        for (int ai = 0; ai < 2; ++ai)
#pragma unroll
            for (int m = 0; m < 4; ++m) {
                if (ai == 1 && m == 0) {
#pragma unroll
                    for (int m2 = 2; m2 < 4; ++m2)
#pragma unroll
                        for (int bj = 0; bj < 2; ++bj) bq[1][m2][bj] = *(const u32x4*)(hb + (size_t)(row0 + HALF + m2 * 16) * 1024 + col0 + bj * HALF);
                }
                const int row = row0 + ai * HALF + m * 16; float sq = 0.f;
#pragma unroll
                for (int bj = 0; bj < 2; ++bj) {
                    const u32x4 b = bq[ai][m][bj];
                    f32x4 v0, v1;
                    v0[0] = __builtin_bit_cast(float, b.x << 16) + acc[ai][bj][m][0][0]; v0[1] = __builtin_bit_cast(float, b.x & 0xffff0000u) + acc[ai][bj][m][0][1];
                    v0[2] = __builtin_bit_cast(float, b.y << 16) + acc[ai][bj][m][0][2]; v0[3] = __builtin_bit_cast(float, b.y & 0xffff0000u) + acc[ai][bj][m][0][3];
                    v1[0] = __builtin_bit_cast(float, b.z << 16) + acc[ai][bj][m][1][0]; v1[1] = __builtin_bit_cast(float, b.z & 0xffff0000u) + acc[ai][bj][m][1][1];
                    v1[2] = __builtin_bit_cast(float, b.w << 16) + acc[ai][bj][m][1][2]; v1[3] = __builtin_bit_cast(float, b.w & 0xffff0000u) + acc[ai][bj][m][1][3];
                    u32x4 w; w.x = cvt_pk_bf16(v0[0], v0[1]); w.y = cvt_pk_bf16(v0[2], v0[3]); w.z = cvt_pk_bf16(v1[0], v1[1]); w.w = cvt_pk_bf16(v1[2], v1[3]);
                    *(u32x4*)(hb + (size_t)row * 1024 + col0 + bj * HALF) = w;
                    sq += ((v0[0] * v0[0] + v0[1] * v0[1]) + (v0[2] * v0[2] + v0[3] * v0[3])) + ((v1[0] * v1[0] + v1[1] * v1[1]) + (v1[2] * v1[2] + v1[3] * v1[3]));
                }
                sq += __shfl_xor(sq, 16); sq += __shfl_xor(sq, 32);
                if (fq == 0) ss[(size_t)row * 16 + u.pn * 4 + wc] = sq;
            }
    }
};
struct EpiSwiGLU {
    static constexpr bool PERM = true, AFTER_DRAIN = false;
    bf16_t* O; const float* ss;
    __device__ __forceinline__ void operator()(const f32x4 (&acc)[2][2][4][2], const Unit& u, int wr, int wc, int fr, int fq) const {
        const int row0 = u.pm * BM + wr * 64 + fr, col = u.pn * HALF + wc * 32 + 8 * fq;
        float rsv[2][4]; rows_rstd8(ss, row0, fq, rsv);
#pragma unroll
        for (int ai = 0; ai < 2; ++ai)
#pragma unroll
            for (int m = 0; m < 4; ++m) {
                const int row = row0 + ai * HALF + m * 16; const float rs = rsv[ai][m];
                float o[8];
#pragma unroll
                for (int n = 0; n < 2; ++n)
#pragma unroll
                    for (int k = 0; k < 4; ++k) { const float a = acc[ai][0][m][n][k] * rs, b = acc[ai][1][m][n][k] * rs; o[n * 4 + k] = a * b * __builtin_amdgcn_rcpf(1.0f + __builtin_amdgcn_exp2f(-1.4426950408889634f * a)); }
                u32x4 w; w.x = cvt_pk_bf16(o[0], o[1]); w.y = cvt_pk_bf16(o[2], o[3]); w.z = cvt_pk_bf16(o[4], o[5]); w.w = cvt_pk_bf16(o[6], o[7]);
                *(u32x4*)(O + (size_t)row * 2816 + col) = w;
            }
    }
};
template <class Epi, class Sched, bool ALIGN_EPI = false, bool SP2 = false>
__device__ __forceinline__ void gemm_phase(PG8_LAS unsigned char* lds, const Gemm g, const Sched& S, const Epi& E) {
    int tid_ = threadIdx.x; asm volatile("" : "+v"(tid_)); const int tid = tid_, wid = __builtin_amdgcn_readfirstlane(tid >> 6), lane = tid & 63, wr = wid >> 2, wc = wid & 3, fr = lane & 15, fq = lane >> 4;
    const int K = g.K, nt = K / BK;
    unsigned voffA[2], voffB[2];
#pragma unroll
    for (int i = 0; i < 2; ++i) { int R, C; stage_rc(tid * 16 + i * 8192, R, C); const int Rb = Epi::PERM ? ((R & ~31) + perm32(R & 31)) : R;
        voffA[i] = (unsigned)(R * K + C) * 2u; voffB[i] = (unsigned)(Rb * K + C) * 2u; }
    const size_t kstep = (size_t)(BK * 2);
    const size_t hstep = (size_t)HALF * K * 2;
    const size_t tstep = 2 * hstep;
    const unsigned ldsw = (unsigned)wid * 1024u;
    const int aoff = lds_byte(wr * 64 + fr, fq * 8), boff = lds_byte(wc * 32 + fr, fq * 8);
#define PG8_SA(b, h) (((b) * 2 + (h)) * HTB)
#define PG8_SB(b, h) ((4 + (b) * 2 + (h)) * HTB)
#define PG8_STAGE(bufoff, gbase, voff) do { _Pragma("unroll") for (int _i = 0; _i < 2; ++_i) \
        __builtin_amdgcn_global_load_lds((const unsigned*)((const char*)(gbase) + (voff)[_i]), (PG8_LAS unsigned*)(lds + (bufoff) + ldsw + _i * 8192), 16, 0, 0); } while (0)
#define PG8_LDA(dst, b, h) do { _Pragma("unroll") for (int m = 0; m < 4; ++m) _Pragma("unroll") for (int k = 0; k < 2; ++k) dst[m][k] = *(const PG8_LAS bf16x8*)(lds + PG8_SA(b, h) + aoff + m * 2048 + k * 1024); } while (0)
#define PG8_LDB(dst, b, h) do { _Pragma("unroll") for (int n = 0; n < 2; ++n) _Pragma("unroll") for (int k = 0; k < 2; ++k) dst[n][k] = *(const PG8_LAS bf16x8*)(lds + PG8_SB(b, h) + boff + n * 2048 + k * 1024); } while (0)
#define PG8_MMA(ai, bj, At, Bt) do { __builtin_amdgcn_s_setprio(1); _Pragma("unroll") for (int m = 0; m < 4; ++m) _Pragma("unroll") for (int n = 0; n < 2; ++n) _Pragma("unroll") for (int k = 0; k < 2; ++k) \
        acc[ai][bj][m][n] = __builtin_amdgcn_mfma_f32_16x16x32_bf16(Bt[n][k], At[m][k], acc[ai][bj][m][n], 0, 0, 0); __builtin_amdgcn_s_setprio(0); } while (0)
#define PG8_WAIT_V(n) asm volatile("s_waitcnt vmcnt(" #n ")" ::: "memory")
#define PG8_WAIT_L(n) asm volatile("s_waitcnt lgkmcnt(" #n ")" ::: "memory")
#define PG8_BAR __builtin_amdgcn_s_barrier()
#define PG8_SCHED __builtin_amdgcn_sched_barrier(0)
    Unit cur, nxt; int ui = 0;
    if (!S.next(0, cur)) return;
    f32x4 acc[2][2][4][2];
#pragma unroll
    for (int a = 0; a < 2; ++a)
#pragma unroll
        for (int b = 0; b < 2; ++b)
#pragma unroll
            for (int m = 0; m < 4; ++m)
#pragma unroll
                for (int n = 0; n < 2; ++n) acc[a][b][m][n] = (f32x4){0.f, 0.f, 0.f, 0.f};
    bf16x8 At[4][2], B0[2][2], B1[2][2];
    const char* cA = (const char*)g.A + (size_t)cur.pm * tstep; const char* cB = (const char*)g.Bt + (size_t)cur.pn * tstep;
    S.a_ready(cur);
    if constexpr (SP2) {
        PG8_STAGE(PG8_SB(0, 0), cB, voffB); PG8_STAGE(PG8_SB(0, 1), cB + hstep, voffB); PG8_STAGE(PG8_SA(0, 0), cA, voffA); PG8_STAGE(PG8_SA(0, 1), cA + hstep, voffA);
        if (wr == 1) PG8_BAR;
        PG8_WAIT_V(2); PG8_BAR;
        PG8_STAGE(PG8_SB(1, 0), cB + kstep, voffB); PG8_STAGE(PG8_SA(1, 0), cA + kstep, voffA); PG8_STAGE(PG8_SB(1, 1), cB + hstep + kstep, voffB);
        PG8_WAIT_V(6); PG8_BAR;
    } else {
        PG8_STAGE(PG8_SB(0, 0), cB, voffB); PG8_STAGE(PG8_SA(0, 0), cA, voffA); PG8_STAGE(PG8_SB(0, 1), cB + hstep, voffB); PG8_STAGE(PG8_SA(0, 1), cA + hstep, voffA);
        if (wr == 1) PG8_BAR;
        PG8_WAIT_V(4); PG8_BAR;
        PG8_STAGE(PG8_SB(1, 0), cB + kstep, voffB); PG8_STAGE(PG8_SA(1, 0), cA + kstep, voffA); PG8_STAGE(PG8_SB(1, 1), cB + hstep + kstep, voffB);
        PG8_WAIT_V(6); PG8_BAR;
    }
    for (;;) {
        const bool has_next = S.next(ui + 1, nxt);
        const char* nA = has_next ? (const char*)g.A + (size_t)nxt.pm * tstep : cA; const char* nB = has_next ? (const char*)g.Bt + (size_t)nxt.pn * tstep : cB;
        for (int t = 0; t < nt; t += 2) {
            const bool last = (t == nt - 2);
            const char* a1 = cA + (size_t)(t + 1) * kstep;
            const char* a2 = last ? nA : cA + (size_t)(t + 2) * kstep; const char* b2 = last ? nB : cB + (size_t)(t + 2) * kstep;
            const char* a3 = a2 + kstep; const char* b3 = b2 + kstep;
            if (last && has_next) S.a_ready(nxt);
            if constexpr (SP2) {
            PG8_LDB(B0, 0, 0); PG8_LDB(B1, 0, 1); PG8_SCHED; PG8_LDA(At, 0, 0); PG8_STAGE(PG8_SA(1, 1), a1 + hstep, voffA);
            PG8_WAIT_V(8); PG8_WAIT_L(0); PG8_BAR; PG8_MMA(0, 0, At, B0); PG8_MMA(0, 1, At, B1); PG8_BAR; PG8_SCHED;
            PG8_LDA(At, 0, 1); PG8_STAGE(PG8_SB(0, 0), b2, voffB); PG8_STAGE(PG8_SB(0, 1), b2 + hstep, voffB); PG8_STAGE(PG8_SA(0, 0), a2, voffA);
            PG8_WAIT_V(8); PG8_WAIT_L(0); PG8_BAR; PG8_MMA(1, 0, At, B0); PG8_MMA(1, 1, At, B1); PG8_BAR; PG8_SCHED;
            PG8_LDB(B0, 1, 0); PG8_LDB(B1, 1, 1); PG8_SCHED; PG8_LDA(At, 1, 0); PG8_STAGE(PG8_SA(0, 1), a2 + hstep, voffA);
            PG8_WAIT_V(8); PG8_WAIT_L(0); PG8_BAR; PG8_MMA(0, 0, At, B0); PG8_MMA(0, 1, At, B1); PG8_BAR; PG8_SCHED;
            PG8_LDA(At, 1, 1); PG8_STAGE(PG8_SB(1, 0), b3, voffB); PG8_STAGE(PG8_SB(1, 1), b3 + hstep, voffB); PG8_STAGE(PG8_SA(1, 0), a3, voffA);
            PG8_WAIT_V(8); PG8_WAIT_L(0); PG8_BAR; PG8_MMA(1, 0, At, B0); PG8_MMA(1, 1, At, B1); PG8_BAR; PG8_SCHED;
            } else {
            PG8_LDB(B0, 0, 0); PG8_SCHED; PG8_LDA(At, 0, 0); PG8_STAGE(PG8_SA(1, 1), a1 + hstep, voffA);
            PG8_WAIT_L(8); PG8_BAR; PG8_WAIT_L(0); PG8_MMA(0, 0, At, B0); PG8_BAR; PG8_SCHED;
            PG8_LDB(B1, 0, 1); PG8_STAGE(PG8_SB(0, 0), b2, voffB);
            PG8_BAR; PG8_WAIT_L(0); PG8_MMA(0, 1, At, B1); PG8_BAR;
            PG8_LDA(At, 0, 1); PG8_STAGE(PG8_SA(0, 0), a2, voffA);
            PG8_BAR; PG8_WAIT_L(0); PG8_MMA(1, 0, At, B0); PG8_BAR; PG8_SCHED;
            PG8_STAGE(PG8_SB(0, 1), b2 + hstep, voffB);
            PG8_WAIT_V(6); PG8_BAR; PG8_MMA(1, 1, At, B1); PG8_BAR;
            PG8_LDB(B0, 1, 0); PG8_SCHED; PG8_LDA(At, 1, 0); PG8_STAGE(PG8_SA(0, 1), a2 + hstep, voffA);
            PG8_WAIT_L(8); PG8_BAR; PG8_WAIT_L(0); PG8_MMA(0, 0, At, B0); PG8_BAR; PG8_SCHED;
            PG8_LDB(B1, 1, 1); PG8_STAGE(PG8_SB(1, 0), b3, voffB);
            PG8_BAR; PG8_WAIT_L(0); PG8_MMA(0, 1, At, B1); PG8_BAR;
            PG8_LDA(At, 1, 1); PG8_STAGE(PG8_SA(1, 0), a3, voffA);
            PG8_BAR; PG8_WAIT_L(0); PG8_MMA(1, 0, At, B0); PG8_BAR; PG8_SCHED;
            PG8_STAGE(PG8_SB(1, 1), b3 + hstep, voffB);
            PG8_WAIT_V(6); PG8_BAR; PG8_MMA(1, 1, At, B1); PG8_BAR;
            }
        }
        if constexpr (ALIGN_EPI) { if (wr == 0) PG8_BAR; }
        if constexpr (!Epi::AFTER_DRAIN) { E(acc, cur, wr, wc, fr, fq); S.done(cur); }
        if (!has_next) break;
#pragma unroll
        for (int a = 0; a < 2; ++a)
#pragma unroll
            for (int b = 0; b < 2; ++b)
#pragma unroll
                for (int m = 0; m < 4; ++m)
#pragma unroll
                    for (int n = 0; n < 2; ++n) acc[a][b][m][n] = (f32x4){0.f, 0.f, 0.f, 0.f};
        cur = nxt; cA = nA; cB = nB; ++ui;
        if constexpr (ALIGN_EPI) { if (wr == 1) PG8_BAR; }
    }
    PG8_WAIT_V(0);
    if constexpr (!ALIGN_EPI) { if (wr == 0) PG8_BAR; }
    PG8_BAR;
    if constexpr (Epi::AFTER_DRAIN) { E.fused(acc, cur, wr, wc, fr, fq, lds, wid, lane); S.done(cur); }
#undef PG8_SA
#undef PG8_SB
#undef PG8_STAGE
#undef PG8_LDA
#undef PG8_LDB
#undef PG8_MMA
#undef PG8_WAIT_V
#undef PG8_WAIT_L
#undef PG8_BAR
#undef PG8_SCHED
}
}
#define LAS __attribute__((address_space(3)))
typedef unsigned short bf16;
typedef short bf16x8 __attribute__((ext_vector_type(8)));
typedef short s16x4 __attribute__((ext_vector_type(4)));
typedef float f32x4 __attribute__((ext_vector_type(4)));
typedef float f32x16 __attribute__((ext_vector_type(16)));
typedef unsigned u32x4 __attribute__((ext_vector_type(4)));
typedef unsigned u32x2 __attribute__((ext_vector_type(2)));
constexpr int NB = 16, SEQ = 2048, DM = 1024, MTOK = NB * SEQ, NH = 16, HD = 64, NG = 4;
constexpr int NSA_W = 2608, NSA_P = 2816, SB_P = 3072, DFF = 2816, DFF2 = 5632;
constexpr float LOG2E = 1.4426950408889634f, LN2 = 0.6931471805599453f;
constexpr size_t MiB = 1u << 20;
constexpr size_t WS_WNSA = 0, WS_WSB = 12 * MiB, WS_WOUT = 24 * MiB, WS_W13 = 32 * MiB, WS_W2 = 76 * MiB, WS_CW1 = 98 * MiB, WS_CW2 = 102 * MiB,
                 WS_CBIAS = 102 * MiB + 256 * 1024, WS_KC = 103 * MiB, WS_VCT = 104 * MiB, WS_SS = 105 * MiB, WS_GATES = 107 * MiB, WS_HB = 114 * MiB,
                 WS_O = 178 * MiB, WS_PROJ = 242 * MiB, WS_CTL = 436 * MiB, WS_END = 437 * MiB;
constexpr int LDS_BYTES = 147456 + 1024;
#ifndef TSEL
#define TSEL -1
#endif

struct Params { const float* in[15]; float* out; unsigned char* ws; int ph_lo, ph_hi; };

__device__ __forceinline__ unsigned f2bf(float f) { unsigned u = __builtin_bit_cast(unsigned, f); return (u + 0x7fffu + ((u >> 16) & 1u)) >> 16; }
__device__ __forceinline__ unsigned pk2(float lo, float hi) { return pg8::cvt_pk_bf16(lo, hi); }
__device__ __forceinline__ float wave_sum(float v) {
#pragma unroll
    for (int o = 1; o < 64; o <<= 1) v += __shfl_xor(v, o);
    return v;
}
__device__ __forceinline__ float swap32(float v) {
    const unsigned u = __builtin_bit_cast(unsigned, v);
    auto rr = __builtin_amdgcn_permlane32_swap(u, u, false, false);
    return __builtin_bit_cast(float, (threadIdx.x & 32) ? (unsigned)rr[0] : (unsigned)rr[1]);
}
__device__ __forceinline__ int crow(int r, int hi) { return (r & 3) + 8 * (r >> 2) + 4 * hi; }
__device__ __forceinline__ bf16x8 pack8(float a0, float a1, float a2, float a3, float a4, float a5, float a6, float a7) {
    u32x4 w; w.x = pk2(a0, a1); w.y = pk2(a2, a3); w.z = pk2(a4, a5); w.w = pk2(a6, a7); return __builtin_bit_cast(bf16x8, w);
}
typedef short v4i16_t __attribute__((ext_vector_type(4)));
__device__ __forceinline__ s16x4 vtr(const LAS unsigned char* p) { return __builtin_bit_cast(s16x4, __builtin_amdgcn_ds_read_tr16_b64_v4i16((LAS v4i16_t*)p)); }
#define MFMA32(a, b, c) __builtin_amdgcn_mfma_f32_32x32x16_bf16((a), (b), (c), 0, 0, 0)
#define MFMA16(a, b, c) __builtin_amdgcn_mfma_f32_16x16x32_bf16((a), (b), (c), 0, 0, 0)
#define LDS_FENCE() asm volatile("s_waitcnt lgkmcnt(0)" ::: "memory")

struct TrDesc { const float* W; int K, N; bf16* WT; int ldt; const float* ks; float qscale; int qcols; int mode; };
__device__ __forceinline__ void transpose_item(const TrDesc& d, LAS float* scr, int item, int lane) {
    const int nblk = (d.N + 31) >> 5, kb = item / nblk, nb = item - kb * nblk, k0 = 64 * kb, n0 = 32 * nb;
    const int nn = n0 + (lane & 31);
    float tv[32];
#pragma unroll
    for (int i = 0; i < 32; ++i) { const int kk = 2 * i + (lane >> 5); tv[i] = (nn < d.N) ? d.W[(size_t)(k0 + kk) * d.N + nn] : 0.f; }
    if (d.ks) {
#pragma unroll
        for (int i = 0; i < 32; ++i) tv[i] *= d.ks[k0 + 2 * i + (lane >> 5)];
    }
#pragma unroll
    for (int i = 0; i < 32; ++i) scr[(2 * i + (lane >> 5)) * 33 + (lane & 31)] = tv[i];
    LDS_FENCE();
    const int c = lane & 7;
#pragma unroll
    for (int j = 0; j < 4; ++j) {
        const int nl = (lane >> 3) + 8 * j, n = n0 + nl; const LAS float* s = scr + (8 * c) * 33 + nl;
        const float sc = (n < d.qcols) ? d.qscale : 1.0f;
        u32x4 o; o.x = pk2(s[0 * 33] * sc, s[1 * 33] * sc); o.y = pk2(s[2 * 33] * sc, s[3 * 33] * sc); o.z = pk2(s[4 * 33] * sc, s[5 * 33] * sc); o.w = pk2(s[6 * 33] * sc, s[7 * 33] * sc);
        const int row = d.mode == 0 ? n : (256 * (n >> 7) + (n & 127) + (d.mode == 2 ? 128 : 0));
        const size_t dst = (d.mode == 3) ? ((size_t)((k0 >> 6) * d.N + n) * 64 + 8 * c) : ((size_t)row * d.ldt + k0 + 8 * c);
        if (n < d.N) *(u32x4*)(d.WT + dst) = o;
    }
    LDS_FENCE();
}

__device__ __forceinline__ void prologue(const Params& p, LAS unsigned char* lds, int G) {
    int tid_ = threadIdx.x; asm volatile("" : "+v"(tid_)); const int tid = tid_, lane = tid & 63, wave = __builtin_amdgcn_readfirstlane(tid >> 6);
    LAS float* scr = (LAS float*)(lds + wave * 16384);
    const int gw = blockIdx.x * 8 + wave, NGW = G * 8;
    unsigned char* ws = p.ws;
    const float* mixg = p.in[1]; const float* ffng = p.in[2];
    { constexpr int IT = 16 * 82;
      for (int it = gw; it < 2 * IT; it += NGW) { const int j = it / IT, r = it - j * IT;
        TrDesc d{p.in[4] + (size_t)j * DM * NSA_W, DM, NSA_W, (bf16*)(ws + WS_WNSA) + (size_t)j * NSA_P * DM, DM, mixg + (2 * j) * DM, 0.125f * LOG2E, 1024, 0};
        transpose_item(d, scr, r, lane); } }
    { constexpr int IT = 16 * 96;
      for (int it = gw; it < 2 * IT; it += NGW) { const int j = it / IT, r = it - j * IT;
        TrDesc d{p.in[10] + (size_t)j * DM * SB_P, DM, SB_P, (bf16*)(ws + WS_WSB) + (size_t)j * SB_P * DM, DM, mixg + (2 * j + 1) * DM, 0.125f * LOG2E, 1024, 0};
        transpose_item(d, scr, r, lane); } }
    { constexpr int IT = 16 * 32;
      for (int it = gw; it < 4 * IT; it += NGW) { const int i = it / IT, r = it - i * IT;
        const float* W = ((i & 1) ? p.in[11] : p.in[9]) + (size_t)(i >> 1) * DM * DM;
        TrDesc d{W, DM, DM, (bf16*)(ws + WS_WOUT) + (size_t)i * DM * DM, DM, nullptr, 1.f, 0, 0};
        transpose_item(d, scr, r, lane); } }
    { constexpr int IT = 16 * 88;
      for (int it = gw; it < 8 * IT; it += NGW) { const int q = it / IT, r = it - q * IT, i = q & 3, which = q >> 2;
        TrDesc d{(which ? p.in[13] : p.in[12]) + (size_t)i * DM * DFF, DM, DFF, (bf16*)(ws + WS_W13) + (size_t)i * DFF2 * DM, DM, ffng + i * DM, 1.f, 0, which ? 2 : 1};
        transpose_item(d, scr, r, lane); } }
    { constexpr int IT = 44 * 32;
      for (int it = gw; it < 4 * IT; it += NGW) { const int i = it / IT, r = it - i * IT;
        TrDesc d{p.in[14] + (size_t)i * DFF * DM, DFF, DM, (bf16*)(ws + WS_W2) + (size_t)i * DM * DFF, DFF, nullptr, 1.f, 0, 0};
        transpose_item(d, scr, r, lane); } }
    { constexpr int IT = 32 * 8;
      for (int it = gw; it < 4 * IT; it += NGW) { const int q = it / IT, r = it - q * IT;
        TrDesc d{p.in[7] + (size_t)q * 2048 * 256, 2048, 256, (bf16*)(ws + WS_CW1) + (size_t)q * 256 * 2048, 2048, nullptr, 1.f, 0, 3};
        transpose_item(d, scr, r, lane); } }
    { constexpr int IT = 4 * 2;
      for (int it = gw; it < 4 * IT; it += NGW) { const int q = it / IT, r = it - q * IT;
        TrDesc d{p.in[8] + (size_t)q * 256 * 64, 256, 64, (bf16*)(ws + WS_CW2) + (size_t)q * 64 * 256, 256, nullptr, 1.f, 0, 0};
        transpose_item(d, scr, r, lane); } }
    { const float* x = p.in[0]; bf16* hb = (bf16*)(ws + WS_HB); float* ss = (float*)(ws + WS_SS);
      for (int m0 = gw * 4; m0 < MTOK; m0 += NGW * 4) {
        f32x4 v[4][4]; float sm[4];
#pragma unroll
        for (int q = 0; q < 4; ++q) { const f32x4* xr = (const f32x4*)(x + (size_t)(m0 + q) * DM) + lane;
#pragma unroll
          for (int j = 0; j < 4; ++j) v[q][j] = xr[64 * j]; }
#pragma unroll
        for (int q = 0; q < 4; ++q) { float t = 0.f;
#pragma unroll
          for (int j = 0; j < 4; ++j) t += (v[q][j][0] * v[q][j][0] + v[q][j][1] * v[q][j][1]) + (v[q][j][2] * v[q][j][2] + v[q][j][3] * v[q][j][3]);
          sm[q] = wave_sum(t); }
#pragma unroll
        for (int q = 0; q < 4; ++q) { u32x2* o8 = (u32x2*)(hb + (size_t)(m0 + q) * DM) + lane;
#pragma unroll
          for (int j = 0; j < 4; ++j) { u32x2 w; w.x = pk2(v[q][j][0], v[q][j][1]); w.y = pk2(v[q][j][2], v[q][j][3]); o8[64 * j] = w; } }
        { const int q = lane >> 4, c = lane & 15; const float tot = q == 0 ? sm[0] : q == 1 ? sm[1] : q == 2 ? sm[2] : sm[3]; ss[(size_t)(m0 + q) * 16 + c] = (c == 0) ? tot : 0.f; }
      } }
    { float* part = (float*)(ws + WS_CBIAS);
      for (int t = gw; t < 4 * 32; t += NGW) { const int q = t >> 5, kc = t & 31;
        const float* pe = p.in[6] + (size_t)q * 2048 + kc * 64; const float* W = p.in[7] + (size_t)q * 2048 * 256 + (size_t)kc * 64 * 256;
        f32x4 a = {0.f, 0.f, 0.f, 0.f};
#pragma unroll 16
        for (int k = 0; k < 64; ++k) { const float e = pe[k]; const f32x4 w = *((const f32x4*)(W + (size_t)k * 256) + lane); a += w * e; }
        *((f32x4*)(part + (size_t)(q * 32 + kc) * 256) + lane) = a; } }
    { const int gt = blockIdx.x * 512 + tid, NT = G * 512; constexpr int PER = (NSA_P - NSA_W) * DM * 2 / 16;
      for (int i = gt; i < 2 * PER; i += NT) { const int j = i / PER, r = i - j * PER;
        *((u32x4*)((bf16*)(ws + WS_WNSA) + (size_t)j * NSA_P * DM + (size_t)NSA_W * DM) + r) = (u32x4){0u, 0u, 0u, 0u}; } }
}

__device__ __forceinline__ float gelu_tanh(float v) {
    const float u = 0.7978845608028654f * (v + 0.044715f * v * v * v);
    const float t = 1.0f - 2.0f / (1.0f + __expf(2.0f * u));
    return 0.5f * v * (1.0f + t);
}
__device__ __forceinline__ void compress_phase(const Params& p, LAS unsigned char* lds, int G, int layerj) {
    int tid_ = threadIdx.x; asm volatile("" : "+v"(tid_)); const int tid = tid_, lane = tid & 63, w = __builtin_amdgcn_readfirstlane(tid >> 6), l15 = lane & 15, l4 = lane >> 4;
    unsigned char* ws = p.ws;
    const bf16* proj = (const bf16*)(ws + WS_PROJ);
    LAS bf16* hid = (LAS bf16*)lds;
    for (int unit = blockIdx.x; unit < 256; unit += G) {
        const int kv = unit & 1, half = (unit >> 1) & 1, bg = unit >> 2, b = bg >> 2, g = bg & 3, n0 = half * 64;
        const int q = layerj * 2 + kv;
        const bf16* w1t = (const bf16*)(ws + WS_CW1) + (size_t)q * 256 * 2048;
        const bf16* w2t = (const bf16*)(ws + WS_CW2) + (size_t)q * 64 * 256;
        const float* part = (const float*)(ws + WS_CBIAS) + (size_t)q * 32 * 256;
        const int colbase = (kv ? 1280 : 1024) + g * 64;
        LAS unsigned char* abuf = lds + 36864;
        const bf16* asrc = proj + (size_t)(b * SEQ + 16 * (n0 + (tid >> 3))) * NSA_P + colbase + (tid & 7) * 8;
        const int awr = (tid >> 3) * 144 + (tid & 7) * 16;
        const LAS unsigned char* ard = abuf + l15 * 144 + l4 * 16;
        const bf16* bsrc = w1t + (size_t)(32 * w + l15) * 64 + l4 * 8;
        LAS float* biasl = (LAS float*)(lds + 64 * 264 * 2);
        if (tid < 256) { float pv[32];
#pragma unroll
            for (int kc = 0; kc < 32; ++kc) pv[kc] = part[kc * 256 + tid];
            float bsum = 0.f;
#pragma unroll
            for (int kc = 0; kc < 32; ++kc) bsum += pv[kc];
            biasl[tid] = bsum; }
        f32x4 acc[4][2];
#pragma unroll
        for (int rb = 0; rb < 4; ++rb)
#pragma unroll
            for (int cb = 0; cb < 2; ++cb) acc[rb][cb] = (f32x4){0.f, 0.f, 0.f, 0.f};
        u32x4 ga; bf16x8 fb[2][2][2];
#define CMP_LOADB(buf, l) do { _Pragma("unroll") for (int ks = 0; ks < 2; ++ks) _Pragma("unroll") for (int cb = 0; cb < 2; ++cb) \
            fb[buf][ks][cb] = *(const bf16x8*)(bsrc + (size_t)(l) * 256 * 64 + cb * 16 * 64 + ks * 32); } while (0)
#define CMP_STEP(buf, l) do { \
            bf16x8 fa[2][4]; \
            _Pragma("unroll") for (int ks = 0; ks < 2; ++ks) _Pragma("unroll") for (int rb = 0; rb < 4; ++rb) fa[ks][rb] = *(const LAS bf16x8*)(ard + (buf) * 9216 + rb * 16 * 144 + ks * 64); \
            _Pragma("unroll") for (int ks = 0; ks < 2; ++ks) _Pragma("unroll") for (int rb = 0; rb < 4; ++rb) _Pragma("unroll") for (int cb = 0; cb < 2; ++cb) \
                acc[rb][cb] = MFMA16(fa[ks][rb], fb[buf][ks][cb], acc[rb][cb]); \
            if ((l) + 1 < 32) *(LAS u32x4*)(abuf + ((buf) ^ 1) * 9216 + awr) = ga; \
            if ((l) + 2 < 32) { ga = *(const u32x4*)(asrc + (size_t)((l) + 2) * NSA_P); CMP_LOADB(buf, (l) + 2); } \
            __syncthreads(); } while (0)
        ga = *(const u32x4*)asrc; CMP_LOADB(0, 0);
        *(LAS u32x4*)(abuf + awr) = ga;
        ga = *(const u32x4*)(asrc + NSA_P); CMP_LOADB(1, 1);
        __syncthreads();
#pragma unroll 1
        for (int l = 0; l < 32; l += 2) { CMP_STEP(0, l); CMP_STEP(1, l + 1); }
#undef CMP_LOADB
#undef CMP_STEP
        __syncthreads();
#pragma unroll
        for (int cb = 0; cb < 2; ++cb) {
            const int col = 32 * w + 16 * cb + l15; const float bias = biasl[col];
#pragma unroll
            for (int rb = 0; rb < 4; ++rb)
#pragma unroll
                for (int j = 0; j < 4; ++j) hid[(16 * rb + l4 * 4 + j) * 264 + col] = (bf16)f2bf(gelu_tanh(acc[rb][cb][j] + bias));
        }
        __syncthreads();
        const int rb2 = w >> 1;
        f32x4 o2[2] = {(f32x4){0.f, 0.f, 0.f, 0.f}, (f32x4){0.f, 0.f, 0.f, 0.f}};
#pragma unroll
        for (int ks = 0; ks < 8; ++ks) {
            const bf16x8 a = *(const LAS bf16x8*)(hid + (16 * rb2 + l15) * 264 + ks * 32 + l4 * 8);
#pragma unroll
            for (int c2 = 0; c2 < 2; ++c2) {
                const int cb = 2 * (w & 1) + c2;
                const bf16x8 bb = *(const bf16x8*)(w2t + (size_t)(16 * cb + l15) * 256 + ks * 32 + l4 * 8);
                o2[c2] = MFMA16(a, bb, o2[c2]);
            }
        }
#pragma unroll
        for (int c2 = 0; c2 < 2; ++c2) {
            const int d = 16 * (2 * (w & 1) + c2) + l15, nb = n0 + 16 * rb2 + l4 * 4;
            float v[4];
#pragma unroll
            for (int j = 0; j < 4; ++j) v[j] = (nb + j == 127) ? 0.f : o2[c2][j];
            if (kv == 0) {
                bf16* kc = (bf16*)(ws + WS_KC) + (size_t)((b * 4 + g) * 128) * 64;
#pragma unroll
                for (int j = 0; j < 4; ++j) kc[(size_t)(nb + j) * 64 + d] = (bf16)f2bf(v[j]);
            } else {
                bf16* vct = (bf16*)(ws + WS_VCT) + (size_t)((b * 4 + g) * 64 + d) * 128 + nb;
                u32x2 wv; wv.x = pk2(v[0], v[1]); wv.y = pk2(v[2], v[3]); *(u32x2*)vct = wv;
            }
        }
        __syncthreads();
    }
}
#if TSEL >= 9
#define SECT_INIT() unsigned long long t_sect = __builtin_amdgcn_s_memrealtime()
#define SECT(k) do { if (blockIdx.x == 0 && tid == 0) { const unsigned long long t_now = __builtin_amdgcn_s_memrealtime(); ((LAS unsigned long long*)(lds + 147456 + 800))[k] += t_now - t_sect; t_sect = t_now; } } while (0)
#else
#define SECT_INIT() do {} while (0)
#define SECT(k) do {} while (0)
#endif
struct AttnState { float m, l; f32x16 o0, o1; };
constexpr int KV_BUF = 16384;
template <bool ELEM_MASK>
__device__ __forceinline__ void attn_tile(AttnState& st, const LAS unsigned char* qrl, const LAS unsigned char* kb, const LAS unsigned char* vb,
                                          float base, float slope2, int key0, int tq, int lo_q, int r32, int hi, int lane, bool first) {
    const LAS unsigned char* vp = vb + (4 * hi + ((lane & 15) >> 2)) * 64 + ((lane >> 4) & 1) * 32 + (lane & 3) * 8;
    const int rel = tq - key0 - 4 * hi, rello = lo_q - key0 - 4 * hi;
    f32x16 p0, p1;
    const float hbm = (base + slope2 * (float)(4 * hi)) - st.m;
#pragma unroll
    for (int r = 0; r < 16; ++r) { const int cr = (r & 3) + 8 * (r >> 2); p0[r] = hbm + slope2 * (float)cr; p1[r] = hbm + slope2 * (float)(cr + 32); }
    __builtin_amdgcn_s_setprio(1);
#pragma unroll
    for (int d0 = 0; d0 < 4; ++d0) {
        const bf16x8 k0 = *(const LAS bf16x8*)(kb + (2 * d0 + hi) * 1024 + r32 * 16);
        const bf16x8 k1 = *(const LAS bf16x8*)(kb + (2 * d0 + hi) * 1024 + 512 + r32 * 16);
        const bf16x8 qf = *(const LAS bf16x8*)(qrl + d0 * 1024);
        p0 = MFMA32(k0, qf, p0); p1 = MFMA32(k1, qf, p1);
    }
    __builtin_amdgcn_s_setprio(0);
    float mx = -INFINITY;
#pragma unroll
    for (int r = 0; r < 16; ++r) {
        if (ELEM_MASK) { const int cr = (r & 3) + 8 * (r >> 2); p0[r] = (cr <= rel && cr >= rello) ? p0[r] : -INFINITY; p1[r] = (cr + 32 <= rel && cr + 32 >= rello) ? p1[r] : -INFINITY; }
        mx = fmaxf(mx, fmaxf(p0[r], p1[r]));
    }
    mx = fmaxf(mx, swap32(mx));
    if (!first && __all(mx < -40.f)) return;
    if (first || __any(mx > 0.f)) {
        const float delta = first ? (mx > -1e30f ? mx : 0.f) : fmaxf(mx, 0.f);
        const float alpha = __builtin_amdgcn_exp2f(-delta);
        st.m += delta; st.l *= alpha;
#pragma unroll
        for (int r = 0; r < 16; ++r) { st.o0[r] *= alpha; st.o1[r] *= alpha; p0[r] -= delta; p1[r] -= delta; }
    }
    float rs = 0.f;
#pragma unroll
    for (int r = 0; r < 16; ++r) { p0[r] = __builtin_amdgcn_exp2f(p0[r]); p1[r] = __builtin_amdgcn_exp2f(p1[r]); rs += p0[r] + p1[r]; }
    st.l += rs;
    bf16x8 pb[4];
    pb[0] = pack8(p0[0], p0[1], p0[2], p0[3], p0[4], p0[5], p0[6], p0[7]);
    pb[1] = pack8(p0[8], p0[9], p0[10], p0[11], p0[12], p0[13], p0[14], p0[15]);
    pb[2] = pack8(p1[0], p1[1], p1[2], p1[3], p1[4], p1[5], p1[6], p1[7]);
    pb[3] = pack8(p1[8], p1[9], p1[10], p1[11], p1[12], p1[13], p1[14], p1[15]);
    __builtin_amdgcn_s_setprio(1);
#pragma unroll
    for (int ks = 0; ks < 4; ++ks) {
        const s16x4 a0 = vtr(vp + ks * 1024), a1 = vtr(vp + ks * 1024 + 512), c0 = vtr(vp + 4096 + ks * 1024), c1 = vtr(vp + 4096 + ks * 1024 + 512);
        const bf16x8 v0 = __builtin_shufflevector(a0, a1, 0, 1, 2, 3, 4, 5, 6, 7);
        const bf16x8 v1 = __builtin_shufflevector(c0, c1, 0, 1, 2, 3, 4, 5, 6, 7);
        st.o0 = MFMA32(v0, pb[ks], st.o0); st.o1 = MFMA32(v1, pb[ks], st.o1);
    }
    __builtin_amdgcn_s_setprio(0);
}

constexpr int CMPV_PITCH = 264, IMP_OFF = 34816, SELM_OFF = IMP_OFF + 4 * 64 * 33 * 4, OACC_OFF = SELM_OFF + 256;
__device__ __forceinline__ void nsa_tiles(AttnState& st, LAS unsigned char* lds, unsigned tilesS, unsigned tilesW, const bf16* kvbase  ,
                                          unsigned mysel, float slope2, int tq, int qt, int lane, int w, u32x4 kA, u32x4 vA, float gate_s  ) {
    asm volatile("" : "+v"(lane));
    const int r32 = lane & 31, hi = lane >> 5;
    const LAS unsigned char* qrl = lds + IMP_OFF + w * 4096 + lane * 16;
    const bf16* ksrc = kvbase + (size_t)lane * NSA_P + w * 8;
    const bf16* vsrc = kvbase + 256 + (size_t)(16 * (w & 3) + (lane >> 2)) * NSA_P + (w >> 2) * 32 + (lane & 3) * 8;
    const int sto = w * 1024 + lane * 16;
    unsigned remS = tilesS & ~(1u << qt), remW = tilesW;
#define NSA_POP(code) do { if (remS) { const int j_ = 31 - __builtin_clz(remS); remS &= ~(1u << j_); code = j_; } \
                          else if (remW) { const int j_ = 31 - __builtin_clz(remW); remW &= ~(1u << j_); code = 32 + j_; } else code = -1; } while (0)
#define NSA_FETCH(KR, VR, code) do { const int cc_ = (code) >= 0 ? (code) : qt;     \
        const size_t off_ = (size_t)(cc_ & 31) * 64 * NSA_P + (cc_ >> 5) * 512; KR = *(const u32x4*)(ksrc + off_); VR = *(const u32x4*)(vsrc + off_); } while (0)
    int c0 = qt, c1, c2; bool first = true;
    u32x4 kB, vB;
    NSA_POP(c1); NSA_FETCH(kB, vB, c1);
    *(LAS u32x4*)(lds + sto) = kA; *(LAS u32x4*)(lds + 8192 + sto) = vA;
    __syncthreads();
    int buf = 0;
#define NSA_STEP(KN, VN, KF, VF) do { \
        NSA_POP(c2); NSA_FETCH(KF, VF, c2); \
        { const int phase = c0 >> 5, j = c0 & 31; \
          const LAS unsigned char* kb = lds + buf * KV_BUF; const LAS unsigned char* vb = kb + 8192; \
          const bool selq = phase ? true : (((mysel >> j) & 1u) != 0u); \
          const float base = selq ? slope2 * (float)(64 * j - tq) : -INFINITY; \
          const int lo_q = phase ? tq - 511 : -(1 << 30); \
          if (j == qt || (phase && j == qt - 8)) attn_tile<true>(st, qrl, kb, vb, base, slope2, 64 * j, tq, lo_q, r32, hi, lane, first); \
          else attn_tile<false>(st, qrl, kb, vb, base, slope2, 64 * j, tq, lo_q, r32, hi, lane, false); } \
        { LAS unsigned char* nb = lds + (buf ^ 1) * KV_BUF; *(LAS u32x4*)(nb + sto) = KN; *(LAS u32x4*)(nb + 8192 + sto) = VN; }     \
        __syncthreads(); \
        first = false; \
        if (c1 >= 0 && (c1 >> 5) != (c0 >> 5)) {     \
            first = true; \
            LAS float* oacc2 = (LAS float*)(lds + OACC_OFF) + w * 2048 + lane; \
            const float lt = st.l + swap32(st.l); const float sc = gate_s / lt; \
            _Pragma("unroll") for (int r = 0; r < 16; ++r) { oacc2[r * 64] += st.o0[r] * sc; oacc2[(16 + r) * 64] += st.o1[r] * sc; } \
            st.m = 0.f; st.l = 0.f; \
            _Pragma("unroll") for (int r = 0; r < 16; ++r) { st.o0[r] = 0.f; st.o1[r] = 0.f; } } \
        c0 = c1; c1 = c2; buf ^= 1; } while (0)
    for (;;) {
        NSA_STEP(kB, vB, kA, vA);
        if (c0 < 0) break;
        NSA_STEP(kA, vA, kB, vB);
        if (c0 < 0) break;
    }
#undef NSA_POP
#undef NSA_FETCH
#undef NSA_STEP
}

__device__ __forceinline__ void nsa_attn_phase(const Params& p, LAS unsigned char* lds, int G) {
    int tid_ = threadIdx.x; asm volatile("" : "+v"(tid_)); const int tid = tid_, lane = tid & 63, w = __builtin_amdgcn_readfirstlane(tid >> 6), r32 = lane & 31, hi = lane >> 5, hh = w & 3, tb = w >> 2;
    unsigned char* ws = p.ws;
    const bf16* proj = (const bf16*)(ws + WS_PROJ);
    const float* gates = (const float*)(ws + WS_GATES);
    bf16* obuf = (bf16*)(ws + WS_O);
    LAS float* impw = (LAS float*)(lds + IMP_OFF);
    LAS unsigned* selm = (LAS unsigned*)(lds + SELM_OFF);
    for (int u = blockIdx.x; u < 2048; u += G) {
        SECT_INIT();
        int bg, qt;
        if (G == 256) { const int r = u >> 8, k = u & 255, c = k >> 6; bg = (k & 63) ^ (r & 3); qt = (r & 1) ? 4 * r + 3 - c : 4 * r + c; }
        else { bg = u & 63; qt = u >> 6; }
        const int b = bg >> 2, g = bg & 3, head = 4 * g + hh;
        const float slope2 = __builtin_amdgcn_exp2f(-0.5f * (float)(head + 1)) * LOG2E;
        const int tq = 64 * qt + 32 * tb + r32; const size_t row = (size_t)b * SEQ + tq;
        bf16x8 qr[4];
        { const bf16* qp = proj + row * NSA_P + head * 64 + hi * 8;
#pragma unroll
          for (int d0 = 0; d0 < 4; ++d0) qr[d0] = *(const bf16x8*)(qp + d0 * 16); }
        const float gate_c = gates[row * 48 + head], gate_s = gates[row * 48 + 16 + head], gate_w = gates[row * 48 + 32 + head];
        LAS float* oacc = (LAS float*)(lds + OACC_OFF) + w * 2048 + lane;
        const bf16* kvbase = proj + (size_t)b * SEQ * NSA_P + 1536 + g * 64;
        const u32x4 kreg0 = *(const u32x4*)(kvbase + (size_t)(64 * qt + lane) * NSA_P + w * 8);
        const u32x4 vreg0 = *(const u32x4*)(kvbase + 256 + (size_t)(64 * qt + 16 * (w & 3) + (lane >> 2)) * NSA_P + (w >> 2) * 32 + (lane & 3) * 8);
        {
            const int nct = (4 * qt + 3 + 31) >> 5;
            const bf16* kcb = (const bf16*)(ws + WS_KC) + (size_t)((b * 4 + g) * 128) * 64;
            const bf16* vctb = (const bf16*)(ws + WS_VCT) + (size_t)((b * 4 + g) * 64) * 128;
            {
                u32x4 kk[2], vv[2];
#pragma unroll
                for (int i = 0; i < 2; ++i) { const int id = tid + 512 * i; kk[i] = *(const u32x4*)(kcb + (size_t)(id >> 3) * 64 + (id & 7) * 8); vv[i] = *(const u32x4*)(vctb + (size_t)(id >> 4) * 128 + (id & 15) * 8); }
#pragma unroll
                for (int i = 0; i < 2; ++i) { const int id = tid + 512 * i;
                    *(LAS u32x4*)(lds + (id & 7) * 2048 + (id >> 3) * 16) = kk[i];
                    LAS unsigned char* vd = lds + 16384 + (id >> 4) * CMPV_PITCH + (id & 15) * 16;
                    *(LAS u32x2*)vd = (u32x2){vv[i].x, vv[i].y}; *(LAS u32x2*)(vd + 8) = (u32x2){vv[i].z, vv[i].w}; }
            }
            __syncthreads();
            const LAS unsigned char* kcl = lds + hi * 2048 + r32 * 16;
            const LAS unsigned char* vcl = lds + 16384 + r32 * CMPV_PITCH + 8 * hi;
            float m = -1e30f, l = 0.f;
#pragma unroll 1
            for (int t = 0; t < nct; ++t) {
                f32x16 a;
#pragma unroll
                for (int r = 0; r < 16; ++r) a[r] = 0.f;
#pragma unroll
                for (int d0 = 0; d0 < 4; ++d0) { const bf16x8 kf = *(const LAS bf16x8*)(kcl + d0 * 4096 + t * 512); a = MFMA32(kf, qr[d0], a); }
                float mx = -INFINITY;
#pragma unroll
                for (int r = 0; r < 16; ++r) { const int n = 32 * t + crow(r, hi), cend = 16 * n + 31; const float sv = a[r] + slope2 * (float)(cend - tq); a[r] = (cend <= tq) ? sv : -INFINITY; mx = fmaxf(mx, a[r]); }
                mx = fmaxf(mx, swap32(mx));
                const float mnew = fmaxf(m, mx); float rs = 0.f;
#pragma unroll
                for (int r = 0; r < 16; ++r) rs += __builtin_amdgcn_exp2f(a[r] - mnew);
                l = l * __builtin_amdgcn_exp2f(m - mnew) + rs; m = mnew;
            }
            l += swap32(l);
            const float inv = (l > 0.f) ? 1.0f / l : 0.f;
            LAS float* myimp = impw + (hh * 64 + tb * 32 + r32) * 33;
            float carry3 = 0.f;
            f32x16 out0, out1;
#pragma unroll
            for (int r = 0; r < 16; ++r) { out0[r] = 0.f; out1[r] = 0.f; }
#pragma unroll 1
            for (int t = 0; t < nct; ++t) {
                f32x16 a;
#pragma unroll
                for (int r = 0; r < 16; ++r) a[r] = 0.f;
#pragma unroll
                for (int d0 = 0; d0 < 4; ++d0) { const bf16x8 kf = *(const LAS bf16x8*)(kcl + d0 * 4096 + t * 512); a = MFMA32(kf, qr[d0], a); }
#pragma unroll
                for (int r = 0; r < 16; ++r) { const int n = 32 * t + crow(r, hi), cend = 16 * n + 31; const float sv = a[r] + slope2 * (float)(cend - tq); a[r] = (cend <= tq) ? __builtin_amdgcn_exp2f(sv - m) * inv : 0.f; }
                float rcv[4];
#pragma unroll
                for (int i = 0; i < 4; ++i) rcv[i] = swap32(a[4 * i + 3]);
#pragma unroll
                for (int i = 0; i < 4; ++i) {
                    const float own = 2.0f * (a[4 * i] + a[4 * i + 1] + a[4 * i + 2]) + a[4 * i + 3];
                    const float prev = hi ? rcv[i] : (i == 0 ? carry3 : rcv[i - 1]);
                    myimp[8 * t + 2 * i + hi] = own + prev;
                }
                carry3 = rcv[3];
#pragma unroll
                for (int ks = 0; ks < 2; ++ks) {
                    const bf16x8 pbk = pack8(a[8 * ks], a[8 * ks + 1], a[8 * ks + 2], a[8 * ks + 3], a[8 * ks + 4], a[8 * ks + 5], a[8 * ks + 6], a[8 * ks + 7]);
                    const LAS unsigned char* v0p = vcl + t * 64 + ks * 32;
                    const s16x4 a0 = *(const LAS s16x4*)v0p, a1 = *(const LAS s16x4*)(v0p + 16), c0 = *(const LAS s16x4*)(v0p + 32 * CMPV_PITCH), c1 = *(const LAS s16x4*)(v0p + 32 * CMPV_PITCH + 16);
                    const bf16x8 v0 = __builtin_shufflevector(a0, a1, 0, 1, 2, 3, 4, 5, 6, 7);
                    const bf16x8 v1 = __builtin_shufflevector(c0, c1, 0, 1, 2, 3, 4, 5, 6, 7);
                    out0 = MFMA32(v0, pbk, out0); out1 = MFMA32(v1, pbk, out1);
                }
            }
            const float gc = gate_c;
#pragma unroll
            for (int r = 0; r < 16; ++r) { oacc[r * 64] = out0[r] * gc; oacc[(16 + r) * 64] = out1[r] * gc; }
        }
        __syncthreads();
        SECT(0);
        for (int idx = tid; idx < 64 * 32; idx += 512) { const int q = idx >> 5, jj = idx & 31; LAS float* a = impw + q * 33 + jj;
            a[0] = (a[0] + a[64 * 33]) + (a[2 * 64 * 33] + a[3 * 64 * 33]); }
        __syncthreads();
        if (qt + 1 <= 8) { if (tid < 64) selm[tid] = (1u << (qt + 1)) - 1u; }
        else {
#pragma unroll 1
            for (int it = 0; it < 4; ++it) {
                const int q = 8 * w + 2 * it + hi, jj = r32;
                const LAS float* rowp = impw + q * 33;
                const float my = rowp[jj]; int cnt = 0;
                float rv[32];
#pragma unroll
                for (int j2 = 0; j2 < 32; ++j2) rv[j2] = rowp[j2];
#pragma unroll
                for (int j2 = 1; j2 < 31; ++j2) cnt += (j2 <= qt - 2 && (rv[j2] > my || (rv[j2] == my && j2 < jj))) ? 1 : 0;
                const bool forced = (jj == 0) || (jj == qt) || (jj == qt - 1);
                const bool cand = (jj >= 1) && (jj <= qt - 2);
                const bool sel = forced || (cand && cnt < 5);
                const unsigned long long bal = __ballot(sel);
                if (r32 == 0) selm[q] = hi ? (unsigned)(bal >> 32) : (unsigned)bal;
            }
        }
        __syncthreads();
        const unsigned mysel = selm[tb * 32 + r32];
        unsigned uni = selm[lane];
#pragma unroll
        for (int o = 1; o < 64; o <<= 1) uni |= __shfl_xor(uni, o);
        uni = __builtin_amdgcn_readfirstlane(uni);
        LAS unsigned char* qrl = lds + IMP_OFF + w * 4096 + lane * 16;
#pragma unroll
        for (int d0 = 0; d0 < 4; ++d0) *(LAS bf16x8*)(qrl + d0 * 1024) = qr[d0];
        SECT(1);
        {
            AttnState st; st.m = 0.f; st.l = 0.f;
#pragma unroll
            for (int r = 0; r < 16; ++r) { st.o0[r] = 0.f; st.o1[r] = 0.f; }
            const int jlo = qt >= 8 ? qt - 8 : 0;
            const unsigned tilesW = (unsigned)(((1ull << (qt + 1)) - 1ull) & ~((1ull << jlo) - 1ull));
            nsa_tiles(st, lds, uni, tilesW, kvbase, mysel, slope2, tq, qt, lane, w, kreg0, vreg0, gate_s);
            SECT(2);
            int l2 = lane; asm volatile("" : "+v"(l2)); const size_t row2 = (size_t)b * SEQ + 64 * qt + 32 * tb + (l2 & 31); LAS float* oacc2 = (LAS float*)(lds + OACC_OFF) + w * 2048 + l2;
            const float lt = st.l + swap32(st.l); const float sc = gate_w / lt;
            f32x16 out0, out1;
#pragma unroll
            for (int r = 0; r < 16; ++r) { out0[r] = oacc2[r * 64] + st.o0[r] * sc; out1[r] = oacc2[(16 + r) * 64] + st.o1[r] * sc; }
          bf16* op = obuf + row2 * DM + head * 64 + 4 * (l2 >> 5);
#pragma unroll
          for (int i = 0; i < 4; ++i) {
            u32x2 w0; w0.x = pk2(out0[4 * i], out0[4 * i + 1]); w0.y = pk2(out0[4 * i + 2], out0[4 * i + 3]); *(u32x2*)(op + 8 * i) = w0;
            u32x2 w1; w1.x = pk2(out1[4 * i], out1[4 * i + 1]); w1.y = pk2(out1[4 * i + 2], out1[4 * i + 3]); *(u32x2*)(op + 32 + 8 * i) = w1; } }
        SECT(3);
    }
}
__device__ __forceinline__ void sb_attn_phase(const Params& p, LAS unsigned char* lds, int G) {
    int tid_ = threadIdx.x; asm volatile("" : "+v"(tid_)); const int tid = tid_, lane = tid & 63, w = __builtin_amdgcn_readfirstlane(tid >> 6), r32 = lane & 31, hi = lane >> 5;
    unsigned char* ws = p.ws;
    const bf16* proj = (const bf16*)(ws + WS_PROJ);
    bf16* obuf = (bf16*)(ws + WS_O);
    LAS unsigned char* vl = lds + w * 4096;
    const LAS unsigned char* vp = vl + (4 * hi + ((lane & 15) >> 2)) * 64 + ((lane >> 4) & 1) * 32 + (lane & 3) * 8;
    const int gw = blockIdx.x * 8 + w, NGW = G * 8;
    for (int u = gw; u < NB * NH * 64; u += NGW) {
        const int qb = u & 63, head = (u >> 6) & 15, b = u >> 10;
        const int tq = 32 * qb + r32; const size_t row = (size_t)b * SEQ + tq;
        bf16x8 qr[4];
        { const bf16* qp = proj + row * SB_P + head * 64 + hi * 8;
#pragma unroll
          for (int d0 = 0; d0 < 4; ++d0) qr[d0] = *(const bf16x8*)(qp + d0 * 16); }
        const bf16* kbase = proj + (size_t)b * SEQ * SB_P + 1024 + head * 64;
        const bf16* vbase = proj + (size_t)b * SEQ * SB_P + 2048 + head * 64;
        f32x16 o0, o1;
#pragma unroll
        for (int r = 0; r < 16; ++r) { o0[r] = 0.f; o1[r] = 0.f; }
        float carry = 0.f;
        u32x4 vrA[4], vrB[4]; bf16x8 kfA[4], kfB[4];
#define SB_LOAD(VR, KF, kt_) do { const int key0_ = 32 * (kt_); \
            _Pragma("unroll") for (int i = 0; i < 4; ++i) { const int idx = i * 64 + lane, db = idx >> 7, key = (idx >> 2) & 31, c4 = idx & 3; \
                VR[i] = *(const u32x4*)(vbase + (size_t)(key0_ + key) * SB_P + 32 * db + 8 * c4); } \
            _Pragma("unroll") for (int d0 = 0; d0 < 4; ++d0) KF[d0] = *(const bf16x8*)(kbase + (size_t)(key0_ + r32) * SB_P + d0 * 16 + hi * 8); } while (0)
#define SB_TILE(VR, KF, kt_, DG) do { const int key0 = 32 * (kt_); \
            f32x16 z; \
            _Pragma("unroll") for (int r = 0; r < 16; ++r) z[r] = 0.f; \
            _Pragma("unroll") for (int d0 = 0; d0 < 4; ++d0) z = MFMA32(KF[d0], qr[d0], z); \
            LDS_FENCE(); \
            _Pragma("unroll") for (int i = 0; i < 4; ++i) *(LAS u32x4*)(vl + (i * 64 + lane) * 16) = VR[i]; \
              \
            float L[16]; \
            _Pragma("unroll") for (int r = 0; r < 16; ++r) { \
                const float zz = z[r]; \
                const float sp = fmaxf(zz, 0.f) + __builtin_amdgcn_logf(1.0f + __builtin_amdgcn_exp2f(-fabsf(zz))); \
                L[r] = (!(DG) || (key0 + crow(r, hi)) < tq) ? -sp : 0.f; } \
            float gsum[4], og[4], T[4]; \
            _Pragma("unroll") for (int i = 0; i < 4; ++i) { gsum[i] = (L[4 * i] + L[4 * i + 1]) + (L[4 * i + 2] + L[4 * i + 3]); og[i] = swap32(gsum[i]); T[i] = gsum[i] + og[i]; } \
            float R[4]; R[3] = 0.f; R[2] = T[3]; R[1] = T[3] + T[2]; R[0] = R[1] + T[1]; \
            float a[16]; \
            _Pragma("unroll") for (int i = 0; i < 4; ++i) { \
                const float A = carry + R[i] + (hi ? 0.f : og[i]); \
                const float s3 = A, s2 = s3 + L[4 * i + 3], s1 = s2 + L[4 * i + 2], s0 = s1 + L[4 * i + 1]; \
                const float suf[4] = {s0, s1, s2, s3}; \
                _Pragma("unroll") for (int e4 = 0; e4 < 4; ++e4) { const int r = 4 * i + e4; const float ev = __builtin_amdgcn_exp2f(z[r] + L[r] + suf[e4]); \
                    a[r] = (!(DG) || (key0 + crow(r, hi)) < tq) ? ev : 0.f; } } \
            carry += R[0] + T[0]; \
            const bf16x8 pb0 = pack8(a[0], a[1], a[2], a[3], a[4], a[5], a[6], a[7]), pb1 = pack8(a[8], a[9], a[10], a[11], a[12], a[13], a[14], a[15]); \
            LDS_FENCE(); \
            _Pragma("unroll") for (int ks = 0; ks < 2; ++ks) { \
                const s16x4 a0 = vtr(vp + ks * 1024), a1 = vtr(vp + ks * 1024 + 512), c0 = vtr(vp + 2048 + ks * 1024), c1 = vtr(vp + 2048 + ks * 1024 + 512); \
                const bf16x8 v0 = __builtin_shufflevector(a0, a1, 0, 1, 2, 3, 4, 5, 6, 7); \
                const bf16x8 v1 = __builtin_shufflevector(c0, c1, 0, 1, 2, 3, 4, 5, 6, 7); \
                o0 = MFMA32(v0, ks ? pb1 : pb0, o0); o1 = MFMA32(v1, ks ? pb1 : pb0, o1); } } while (0)
#define SB_DONE(kt_) ((kt_) == 0 || __all(carry < -30.0f))
        SB_LOAD(vrA, kfA, qb);
        if (qb > 0) SB_LOAD(vrB, kfB, qb - 1);
        SB_TILE(vrA, kfA, qb, 1);
        if (!SB_DONE(qb)) {
            for (int kt = qb - 1;;) {
                if (kt > 0) SB_LOAD(vrA, kfA, kt - 1);
                SB_TILE(vrB, kfB, kt, 0);
                if (SB_DONE(kt)) break;
                --kt;
                if (kt > 0) SB_LOAD(vrB, kfB, kt - 1);
                SB_TILE(vrA, kfA, kt, 0);
                if (SB_DONE(kt)) break;
                --kt;
            }
        }
#undef SB_DONE
#undef SB_LOAD
#undef SB_TILE
        LDS_FENCE();
        { bf16* op = obuf + row * DM + head * 64 + 4 * hi;
#pragma unroll
          for (int i = 0; i < 4; ++i) {
            u32x2 w0; w0.x = pk2(o0[4 * i], o0[4 * i + 1]); w0.y = pk2(o0[4 * i + 2], o0[4 * i + 3]); *(u32x2*)(op + 8 * i) = w0;
            u32x2 w1; w1.x = pk2(o1[4 * i], o1[4 * i + 1]); w1.y = pk2(o1[4 * i + 2], o1[4 * i + 3]); *(u32x2*)(op + 32 + 8 * i) = w1; } }
    }
}

__device__ __forceinline__ void final_norm_phase(const Params& p, int G) {
    int tid_ = threadIdx.x; asm volatile("" : "+v"(tid_));
    const int lane = tid_ & 63, gw = blockIdx.x * 8 + __builtin_amdgcn_readfirstlane(tid_ >> 6), NGW = G * 8;
    const float* ss = (const float*)(p.ws + WS_SS); const float* g = p.in[3]; const bf16* hb = (const bf16*)(p.ws + WS_HB);
    f32x4 gv[4];
#pragma unroll
    for (int j = 0; j < 4; ++j) gv[j] = *((const f32x4*)g + lane + 64 * j);
    for (int m0 = gw * 2; m0 < MTOK; m0 += NGW * 2) {
        u32x2 hv[2][4]; float rs[2];
#pragma unroll
        for (int q = 0; q < 2; ++q) { rs[q] = pg8::row_rstd(ss, m0 + q);
#pragma unroll
          for (int j = 0; j < 4; ++j) hv[q][j] = *((const u32x2*)(hb + (size_t)(m0 + q) * DM) + lane + 64 * j); }
#pragma unroll
        for (int q = 0; q < 2; ++q) { f32x4* xr = (f32x4*)(p.out + (size_t)(m0 + q) * DM) + lane;
#pragma unroll
          for (int j = 0; j < 4; ++j) { f32x4 v; v[0] = __builtin_bit_cast(float, hv[q][j].x << 16); v[1] = __builtin_bit_cast(float, hv[q][j].x & 0xffff0000u);
            v[2] = __builtin_bit_cast(float, hv[q][j].y << 16); v[3] = __builtin_bit_cast(float, hv[q][j].y & 0xffff0000u); xr[64 * j] = v * rs[q] * gv[j]; } }
    }
}

#define XB_TMO      128
#define XB_XCNT(j)  (256  + 64 * (j))
#define XB_XSUB(j)  (1280 + 64 * (j))
#define XB_XGEN(j)  (2304 + 64 * (j))
#define XB_TOP      3328
#define XB_TOPGEN   3392
#define XCD_BAR_WORDS 3456
#define XB_SPIN_CAP (1u << 18)

__device__ __forceinline__ unsigned xb_ld(unsigned* p)              { return __hip_atomic_load(p, __ATOMIC_RELAXED, __HIP_MEMORY_SCOPE_AGENT); }
__device__ __forceinline__ unsigned xb_add(unsigned* p, unsigned v) { return __hip_atomic_fetch_add(p, v, __ATOMIC_RELAXED, __HIP_MEMORY_SCOPE_AGENT); }
__device__ __forceinline__ unsigned xb_xcc_id() { return (unsigned)__builtin_amdgcn_s_getreg((3 << 11) | 20) & 0xFu; }
#define XB_SPIN(cond, bar) do { unsigned _sp = 0; while (cond) { __builtin_amdgcn_s_sleep(1); \
    if ((++_sp & 255u) == 0u) { if (xb_ld(&(bar)[XB_TMO])) break; if (_sp > XB_SPIN_CAP) { atomicAdd(&(bar)[XB_TMO], 1u); break; } } } } while (0)

struct XcdBarrier {
    unsigned* bar; unsigned x;
    volatile LAS unsigned* st;
};

__device__ __forceinline__ XcdBarrier xcd_barrier_post(unsigned* bar, volatile LAS unsigned* st) {
    XcdBarrier b; b.bar = bar; b.x = xb_xcc_id(); b.st = st;
    if (threadIdx.x == 0) (void)xb_add(&bar[XB_XCNT(b.x)], 1u);
    return b;
}
__device__ __forceinline__ void xcd_barrier_complete(unsigned* bar, unsigned x, unsigned& nloc, unsigned& nx) {
    const unsigned G = gridDim.x * gridDim.y * gridDim.z;
    unsigned sum, cnt, mine, sp = 0u;
    for (;;) {
        sum = 0u; cnt = 0u; mine = 0u;
#pragma unroll
        for (unsigned j = 0; j < 16; ++j) { const unsigned c = xb_ld(&bar[XB_XCNT(j)]); sum += c; cnt += (c > 0u) ? 1u : 0u; mine = (j == x) ? c : mine; }
        if (sum == G) break;
        __builtin_amdgcn_s_sleep(1);
        if ((++sp & 255u) == 0u) { if (xb_ld(&bar[XB_TMO])) break; if (sp > XB_SPIN_CAP) { atomicAdd(&bar[XB_TMO], 1u); break; } }
    }
    nloc = mine > 0u ? mine : 1u; nx = cnt > 0u ? cnt : 1u;
}

__device__ __forceinline__ void xcd_barrier(const XcdBarrier& b) {
    asm volatile("s_waitcnt vmcnt(0)" ::: "memory");
    __syncthreads();
    if (threadIdx.x == 0) {
        unsigned* bar = b.bar;
        __builtin_amdgcn_s_waitcnt(0);
        unsigned nloc = b.st[0], nx = b.st[1];
        if (nloc == 0u) { xcd_barrier_complete(bar, b.x, nloc, nx); b.st[0] = nloc; b.st[1] = nx; }
        const unsigned old = xb_add(&bar[XB_XSUB(b.x)], 1u);
        const unsigned gen = old / nloc;
        if (old + 1u == (gen + 1u) * nloc) {
            __builtin_amdgcn_fence(__ATOMIC_RELEASE, "agent");
            asm volatile("s_waitcnt vmcnt(0)" ::: "memory");
            const unsigned og = xb_add(&bar[XB_TOP], 1u);
            const unsigned tg = og / nx;
            if (og + 1u == (tg + 1u) * nx) xb_add(&bar[XB_TOPGEN], 1u);
            else XB_SPIN(xb_ld(&bar[XB_TOPGEN]) == tg, bar);
            __builtin_amdgcn_fence(__ATOMIC_ACQUIRE, "agent");
            xb_add(&bar[XB_XGEN(b.x)], 1u);
            asm volatile("s_waitcnt vmcnt(0)" ::: "memory");
        } else {
            XB_SPIN(xb_ld(&bar[XB_XGEN(b.x)]) == gen, bar);
            __builtin_amdgcn_fence(__ATOMIC_ACQUIRE, "agent");
            asm volatile("s_waitcnt vmcnt(0)" ::: "memory");
        }
    }
    __syncthreads();
}

__global__ void __launch_bounds__(512, 2) mega(Params p) {
    extern __shared__ __attribute__((aligned(16))) unsigned char lds_raw[];
    LAS unsigned char* lds = (LAS unsigned char*)lds_raw;
    cg::grid_group grid = cg::this_grid();
    const int G = gridDim.x;
    unsigned char* ws = p.ws;
    bf16* hb = (bf16*)(ws + WS_HB); bf16* proj = (bf16*)(ws + WS_PROJ); bf16* obuf = (bf16*)(ws + WS_O);
    float* ss = (float*)(ws + WS_SS); float* gates = (float*)(ws + WS_GATES);
    volatile LAS unsigned* bst = (volatile LAS unsigned*)(lds + 147456 + 768);
    if (threadIdx.x < 2) bst[threadIdx.x] = 0u;
    if (threadIdx.x < 8) ((LAS unsigned long long*)(lds + 147456 + 800))[threadIdx.x] = 0ull;
    __syncthreads();
    XcdBarrier bar = xcd_barrier_post((unsigned*)(ws + WS_CTL), bst);
    int ph = 0;
    LAS unsigned long long* tsl = (LAS unsigned long long*)(lds + 147456);
    LAS int* kindl = (LAS int*)(lds + 147456 + 512);
    const bool stamper = (TSEL >= 0) && blockIdx.x == 0 && threadIdx.x == 0;
    if (stamper) tsl[0] = __builtin_amdgcn_s_memrealtime();
#define PHASE_ON (ph >= p.ph_lo && ph < p.ph_hi)
#define PHASE_END(kind) do { if (ph >= p.ph_lo && ph + 1 < p.ph_hi) { if (ph == 0) grid.sync(); else xcd_barrier(bar); } if (stamper) { tsl[ph + 1] = __builtin_amdgcn_s_memrealtime(); kindl[ph] = (kind); } ++ph; } while (0)
    if (PHASE_ON) prologue(p, lds, G);
    PHASE_END(0);
#pragma unroll 1
    for (int i = 0; i < 4; ++i) {
        const bool nsa = !(i & 1); const int j = i >> 1;
        if (PHASE_ON) {
            const bf16* Wt = nsa ? (const bf16*)(ws + WS_WNSA) + (size_t)j * NSA_P * DM : (const bf16*)(ws + WS_WSB) + (size_t)j * SB_P * DM;
            const int N = nsa ? NSA_P : SB_P;
            pg8::Gemm g{hb, Wt, MTOK, N, DM}; pg8::StaticOrder S; S.init(MTOK, N, G, (int)blockIdx.x);
            pg8::EpiProj E{proj, N, ss, p.in[5] + j * 48, gates, nsa ? 2560 : (1 << 30)};
            pg8::gemm_phase<pg8::EpiProj, pg8::StaticOrder, true, true>(lds, g, S, E);
        }
        PHASE_END(1);
        if (nsa) {
            if (PHASE_ON) compress_phase(p, lds, G, j);
            PHASE_END(2);
            if (PHASE_ON) nsa_attn_phase(p, lds, G);
            PHASE_END(3);
        } else {
            if (PHASE_ON) sb_attn_phase(p, lds, G);
            PHASE_END(4);
        }
#pragma unroll 1
        for (int s = 0; s < 2; ++s) {
            if (PHASE_ON) {
                const bf16* A = s == 0 ? obuf : proj;
                const bf16* Wt = s == 0 ? (const bf16*)(ws + WS_WOUT) + (size_t)i * DM * DM : (const bf16*)(ws + WS_W2) + (size_t)i * DM * DFF;
                pg8::Gemm g{A, Wt, MTOK, DM, s == 0 ? DM : DFF}; pg8::StaticOrder S; S.init(MTOK, DM, G, (int)blockIdx.x);
                pg8::EpiResid E{hb, ss};
                pg8::gemm_phase<pg8::EpiResid, pg8::StaticOrder, true, true>(lds, g, S, E);
            }
            PHASE_END(5);
            if (s == 0) {
                if (PHASE_ON) {
                    pg8::Gemm g{hb, (const bf16*)(ws + WS_W13) + (size_t)i * DFF2 * DM, MTOK, DFF2, DM}; pg8::StaticOrder S; S.init(MTOK, DFF2, G, (int)blockIdx.x);
                    pg8::EpiSwiGLU E{proj, ss};
                    pg8::gemm_phase<pg8::EpiSwiGLU, pg8::StaticOrder, true, true>(lds, g, S, E);
                }
                PHASE_END(6);
            }
        }
    }
    if (TSEL == 8) { for (int q = 0; q < 10; ++q) { PHASE_END(8); } }
    if (PHASE_ON) final_norm_phase(p, G);
    if (TSEL >= 0) {
        grid.sync();
        if (stamper) { tsl[ph + 1] = __builtin_amdgcn_s_memrealtime(); kindl[ph] = 7; }
        if (blockIdx.x == 0) {
            __syncthreads();
            unsigned long long T = 0;
            for (int k = 0; k <= ph; ++k) if (kindl[k] == TSEL) T += tsl[k + 1] - tsl[k];
            if (TSEL >= 9) T = ((LAS unsigned long long*)(lds + 147456 + 800))[TSEL - 9];
            const int K = (int)(T / 100);
            for (int r = threadIdx.x; r < K && r < MTOK; r += 512) p.out[(size_t)r * DM + 7] += 0.1f;
        }
    }
}

extern "C" void kernel_launch(void* const* d_in, const int* in_sizes, int n_in, void* d_out, int out_size, void* d_ws, size_t ws_size, hipStream_t stream) {
    static int grid = 0;
    if (grid == 0) {
        if (n_in != 15 || out_size != MTOK * DM || ws_size < WS_END) { fprintf(stderr, "kernel_launch: unexpected shapes (n_in %d out %d ws %zu)\n", n_in, out_size, ws_size); grid = -1; return; }
        int dev = 0, cus = 0, per_cu = 0;
        if (hipGetDevice(&dev) != hipSuccess || hipDeviceGetAttribute(&cus, hipDeviceAttributeMultiprocessorCount, dev) != hipSuccess) { grid = -1; return; }
        if (hipFuncSetAttribute((const void*)mega, hipFuncAttributeMaxDynamicSharedMemorySize, LDS_BYTES) != hipSuccess) { fprintf(stderr, "hipFuncSetAttribute failed\n"); grid = -1; return; }
        if (hipOccupancyMaxActiveBlocksPerMultiprocessor(&per_cu, mega, 512, LDS_BYTES) != hipSuccess || per_cu < 1) { fprintf(stderr, "occupancy query failed\n"); grid = -1; return; }
        grid = cus;
    }
    if (grid <= 0) return;
    Params p{};
    for (int i = 0; i < 15; ++i) p.in[i] = (const float*)d_in[i];
    p.out = (float*)d_out; p.ws = (unsigned char*)d_ws; p.ph_lo = 0; p.ph_hi = 1000;
    if (hipMemsetAsync((unsigned char*)d_ws + WS_CTL, 0, XCD_BAR_WORDS * sizeof(unsigned), stream) != hipSuccess) { fprintf(stderr, "memset failed\n"); return; }
    void* args[] = {&p};
    hipError_t e = hipLaunchCooperativeKernel((void*)mega, dim3(grid), dim3(512), args, LDS_BYTES, stream);
    if (e != hipSuccess) fprintf(stderr, "cooperative launch failed: %s (grid %d)\n", hipGetErrorString(e), grid);
}
```

```cpp
#include <hip/hip_runtime.h>
#include <hip/hip_cooperative_groups.h>
#include <cstdio>
#include <cstdint>
#include <cmath>
namespace cg = cooperative_groups;
namespace pg8 {
#define PG8_LAS __attribute__((address_space(3)))
typedef unsigned short bf16_t;
typedef short bf16x8 __attribute__((ext_vector_type(8)));
typedef float f32x4 __attribute__((ext_vector_type(4)));
typedef unsigned u32x4 __attribute__((ext_vector_type(4)));
constexpr int BM = 256, BK = 64, HALF = 128, HTB = HALF * BK * 2  , STAGE_BYTES = 8 * HTB, NXCD = 8, WGM = 8;

__host__ __device__ __forceinline__ int lds_byte(int r, int c) { const int st = (r >> 4) * 2 + (c >> 5), rr = r & 15, cc = c & 31, ob = rr * 64 + cc * 2; return st * 1024 + (ob ^ (((ob >> 9) & 1) << 5)); }
__host__ __device__ __forceinline__ void stage_rc(int b, int& R, int& C) { const int st = b / 1024, sb = b % 1024, swz = sb ^ (((sb >> 9) & 1) << 5); R = (st >> 1) * 16 + swz / 64; C = (st & 1) * 32 + (swz % 64) / 2; }
__host__ __device__ __forceinline__ int perm32(int rho) { const int n = rho >> 4, i = rho & 15; return 8 * (i >> 2) + 4 * n + (i & 3); }

struct Unit { int pm, pn; };
struct Gemm { const bf16_t* A; const bf16_t* Bt; int M, N, K; };

struct StaticOrder {
    int nM, nN, nwg, G, c;
    __host__ __device__ void init(int M, int N, int G_, int c_) { nM = M / BM; nN = N / BM; nwg = nM * nN; G = G_; c = c_; }
    __host__ __device__ bool next(int i, Unit& u) const {
        const long L = (long)i * G + c; if (L >= nwg) return false;
        int wgid = (int)L; { const int q = nwg / NXCD, r = nwg % NXCD, xcd = wgid % NXCD, off = wgid / NXCD; wgid = (xcd < r ? xcd * (q + 1) : r * (q + 1) + (xcd - r) * q) + off; }
        const int nig = WGM * nN, gid = wgid / nig, fm = gid * WGM, gsz = (nM - fm) < WGM ? (nM - fm) : WGM;
        u.pm = fm + ((wgid % nig) % gsz); u.pn = (wgid % nig) / gsz; return true;
    }
    __device__ __forceinline__ void a_ready(const Unit&) const {}
    __device__ __forceinline__ void done(const Unit&) const {}
};

__device__ __forceinline__ unsigned cvt_pk_bf16(float lo, float hi) { unsigned r; asm volatile("v_cvt_pk_bf16_f32 %0, %1, %2" : "=v"(r) : "v"(lo), "v"(hi)); return r; }
typedef unsigned u32x4 __attribute__((ext_vector_type(4)));
typedef float f32x2 __attribute__((ext_vector_type(2)));
__device__ __forceinline__ float row_rstd(const float* ss, int row) {
    const f32x4* p = (const f32x4*)(ss + (size_t)row * 16);
    const f32x4 a = p[0], b = p[1], c = p[2], d = p[3];
    const float s = (((a[0] + a[1]) + (a[2] + a[3])) + ((b[0] + b[1]) + (b[2] + b[3]))) + (((c[0] + c[1]) + (c[2] + c[3])) + ((d[0] + d[1]) + (d[2] + d[3])));
    return rsqrtf(s * (1.0f / 1024.0f) + 1e-6f);
}
__device__ __forceinline__ void rows_rstd8(const float* ss, int row0, int fq, float (&rs)[2][4]) {
    f32x4 v[2][4];
#pragma unroll
    for (int ai = 0; ai < 2; ++ai)
#pragma unroll
        for (int m = 0; m < 4; ++m) v[ai][m] = *(const f32x4*)(ss + (size_t)(row0 + ai * HALF + m * 16) * 16 + 4 * fq);
#pragma unroll
    for (int ai = 0; ai < 2; ++ai)
#pragma unroll
        for (int m = 0; m < 4; ++m) { float t = (v[ai][m][0] + v[ai][m][1]) + (v[ai][m][2] + v[ai][m][3]); t += __shfl_xor(t, 16); t += __shfl_xor(t, 32); rs[ai][m] = rsqrtf(t * (1.0f / 1024.0f) + 1e-6f); }
}
struct EpiProj {
    static constexpr bool PERM = true, AFTER_DRAIN = false;
    bf16_t* O; int ldc; const float* ss; const float* gate_b; float* gates; int gate_col0;
    __device__ __forceinline__ void operator()(const f32x4 (&acc)[2][2][4][2], const Unit& u, int wr, int wc, int fr, int fq) const {
        const int row0 = u.pm * BM + wr * 64 + fr, col0 = u.pn * BM + wc * 32 + 8 * fq;
        float rsv[2][4]; rows_rstd8(ss, row0, fq, rsv);
#pragma unroll
        for (int ai = 0; ai < 2; ++ai)
#pragma unroll
            for (int m = 0; m < 4; ++m) {
                const int row = row0 + ai * HALF + m * 16; const float rs = rsv[ai][m];
#pragma unroll
                for (int bj = 0; bj < 2; ++bj) {
                    const int col = col0 + bj * HALF;
                    const f32x4 v0 = acc[ai][bj][m][0] * rs, v1 = acc[ai][bj][m][1] * rs;
                    if (col >= gate_col0) {
                        if (col < gate_col0 + 48) {
                            const int gc = col - gate_col0; const f32x4 b0 = *(const f32x4*)(gate_b + gc), b1 = *(const f32x4*)(gate_b + gc + 4);
                            f32x4 g0, g1;
#pragma unroll
                            for (int k = 0; k < 4; ++k) { g0[k] = 1.0f / (1.0f + __expf(-(v0[k] + b0[k]))); g1[k] = 1.0f / (1.0f + __expf(-(v1[k] + b1[k]))); }
                            *(f32x4*)(gates + (size_t)row * 48 + gc) = g0; *(f32x4*)(gates + (size_t)row * 48 + gc + 4) = g1;
                        }
                    } else {
                        u32x4 w; w.x = cvt_pk_bf16(v0[0], v0[1]); w.y = cvt_pk_bf16(v0[2], v0[3]); w.z = cvt_pk_bf16(v1[0], v1[1]); w.w = cvt_pk_bf16(v1[2], v1[3]);
                        *(u32x4*)(O + (size_t)row * ldc + col) = w;
                    }
                }
            }
    }
};
struct EpiResid {
    static constexpr bool PERM = true, AFTER_DRAIN = false;
    bf16_t* hb; float* ss;
    __device__ __forceinline__ void operator()(const f32x4 (&acc)[2][2][4][2], const Unit& u, int wr, int wc, int fr, int fq) const {
        const int row0 = u.pm * BM + wr * 64 + fr, col0 = u.pn * BM + wc * 32 + 8 * fq;
        u32x4 bq[2][4][2];
#pragma unroll
        for (int ai = 0; ai < 2; ++ai)
#pragma unroll
            for (int m = 0; m < 4; ++m)
#pragma unroll
                for (int bj = 0; bj < 2; ++bj) if (ai == 0 || m < 2) bq[ai][m][bj] = *(const u32x4*)(hb + (size_t)(row0 + ai * HALF + m * 16) * 1024 + col0 + bj * HALF);
#pragma unroll
        for (int ai = 0; ai < 2; ++ai)
#pragma unroll
            for (int m = 0; m < 4; ++m) {
                if (ai == 1 && m == 0) {
#pragma unroll
                    for (int m2 = 2; m2 < 4; ++m2)
#pragma unroll
                        for (int bj = 0; bj < 2; ++bj) bq[1][m2][bj] = *(const u32x4*)(hb + (size_t)(row0 + HALF + m2 * 16) * 1024 + col0 + bj * HALF);
                }
                const int row = row0 + ai * HALF + m * 16; float sq = 0.f;
#pragma unroll
                for (int bj = 0; bj < 2; ++bj) {
                    const u32x4 b = bq[ai][m][bj];
                    f32x4 v0, v1;
                    v0[0] = __builtin_bit_cast(float, b.x << 16) + acc[ai][bj][m][0][0]; v0[1] = __builtin_bit_cast(float, b.x & 0xffff0000u) + acc[ai][bj][m][0][1];
                    v0[2] = __builtin_bit_cast(float, b.y << 16) + acc[ai][bj][m][0][2]; v0[3] = __builtin_bit_cast(float, b.y & 0xffff0000u) + acc[ai][bj][m][0][3];
                    v1[0] = __builtin_bit_cast(float, b.z << 16) + acc[ai][bj][m][1][0]; v1[1] = __builtin_bit_cast(float, b.z & 0xffff0000u) + acc[ai][bj][m][1][1];
                    v1[2] = __builtin_bit_cast(float, b.w << 16) + acc[ai][bj][m][1][2]; v1[3] = __builtin_bit_cast(float, b.w & 0xffff0000u) + acc[ai][bj][m][1][3];
                    u32x4 w; w.x = cvt_pk_bf16(v0[0], v0[1]); w.y = cvt_pk_bf16(v0[2], v0[3]); w.z = cvt_pk_bf16(v1[0], v1[1]); w.w = cvt_pk_bf16(v1[2], v1[3]);
                    *(u32x4*)(hb + (size_t)row * 1024 + col0 + bj * HALF) = w;
                    sq += ((v0[0] * v0[0] + v0[1] * v0[1]) + (v0[2] * v0[2] + v0[3] * v0[3])) + ((v1[0] * v1[0] + v1[1] * v1[1]) + (v1[2] * v1[2] + v1[3] * v1[3]));
                }
                sq += __shfl_xor(sq, 16); sq += __shfl_xor(sq, 32);
                if (fq == 0) ss[(size_t)row * 16 + u.pn * 4 + wc] = sq;
            }
    }
};
struct EpiSwiGLU {
    static constexpr bool PERM = true, AFTER_DRAIN = false;
    bf16_t* O; const float* ss;
    __device__ __forceinline__ void operator()(const f32x4 (&acc)[2][2][4][2], const Unit& u, int wr, int wc, int fr, int fq) const {
        const int row0 = u.pm * BM + wr * 64 + fr, col = u.pn * HALF + wc * 32 + 8 * fq;
        float rsv[2][4]; rows_rstd8(ss, row0, fq, rsv);
#pragma unroll
        for (int ai = 0; ai < 2; ++ai)
#pragma unroll
            for (int m = 0; m < 4; ++m) {
                const int row = row0 + ai * HALF + m * 16; const float rs = rsv[ai][m];
                float o[8];
#pragma unroll
                for (int n = 0; n < 2; ++n)
#pragma unroll
                    for (int k = 0; k < 4; ++k) { const float a = acc[ai][0][m][n][k] * rs, b = acc[ai][1][m][n][k] * rs; o[n * 4 + k] = a * b * __builtin_amdgcn_rcpf(1.0f + __builtin_amdgcn_exp2f(-1.4426950408889634f * a)); }
                u32x4 w; w.x = cvt_pk_bf16(o[0], o[1]); w.y = cvt_pk_bf16(o[2], o[3]); w.z = cvt_pk_bf16(o[4], o[5]); w.w = cvt_pk_bf16(o[6], o[7]);
                *(u32x4*)(O + (size_t)row * 2816 + col) = w;
            }
    }
};
template <class Epi, class Sched, bool ALIGN_EPI = false, bool SP2 = false>
__device__ __forceinline__ void gemm_phase(PG8_LAS unsigned char* lds, const Gemm g, const Sched& S, const Epi& E) {
    int tid_ = threadIdx.x; asm volatile("" : "+v"(tid_)); const int tid = tid_, wid = __builtin_amdgcn_readfirstlane(tid >> 6), lane = tid & 63, wr = wid >> 2, wc = wid & 3, fr = lane & 15, fq = lane >> 4;
    const int K = g.K, nt = K / BK;
    unsigned voffA[2], voffB[2];
#pragma unroll
    for (int i = 0; i < 2; ++i) { int R, C; stage_rc(tid * 16 + i * 8192, R, C); const int Rb = Epi::PERM ? ((R & ~31) + perm32(R & 31)) : R;
        voffA[i] = (unsigned)(R * K + C) * 2u; voffB[i] = (unsigned)(Rb * K + C) * 2u; }
    const size_t kstep = (size_t)(BK * 2);
    const size_t hstep = (size_t)HALF * K * 2;
    const size_t tstep = 2 * hstep;
    const unsigned ldsw = (unsigned)wid * 1024u;
    const int aoff = lds_byte(wr * 64 + fr, fq * 8), boff = lds_byte(wc * 32 + fr, fq * 8);
#define PG8_SA(b, h) (((b) * 2 + (h)) * HTB)
#define PG8_SB(b, h) ((4 + (b) * 2 + (h)) * HTB)
#define PG8_STAGE(bufoff, gbase, voff) do { _Pragma("unroll") for (int _i = 0; _i < 2; ++_i) \
        __builtin_amdgcn_global_load_lds((const unsigned*)((const char*)(gbase) + (voff)[_i]), (PG8_LAS unsigned*)(lds + (bufoff) + ldsw + _i * 8192), 16, 0, 0); } while (0)
#define PG8_LDA(dst, b, h) do { _Pragma("unroll") for (int m = 0; m < 4; ++m) _Pragma("unroll") for (int k = 0; k < 2; ++k) dst[m][k] = *(const PG8_LAS bf16x8*)(lds + PG8_SA(b, h) + aoff + m * 2048 + k * 1024); } while (0)
#define PG8_LDB(dst, b, h) do { _Pragma("unroll") for (int n = 0; n < 2; ++n) _Pragma("unroll") for (int k = 0; k < 2; ++k) dst[n][k] = *(const PG8_LAS bf16x8*)(lds + PG8_SB(b, h) + boff + n * 2048 + k * 1024); } while (0)
#define PG8_MMA(ai, bj, At, Bt) do { __builtin_amdgcn_s_setprio(1); _Pragma("unroll") for (int m = 0; m < 4; ++m) _Pragma("unroll") for (int n = 0; n < 2; ++n) _Pragma("unroll") for (int k = 0; k < 2; ++k) \
        acc[ai][bj][m][n] = __builtin_amdgcn_mfma_f32_16x16x32_bf16(Bt[n][k], At[m][k], acc[ai][bj][m][n], 0, 0, 0); __builtin_amdgcn_s_setprio(0); } while (0)
#define PG8_WAIT_V(n) asm volatile("s_waitcnt vmcnt(" #n ")" ::: "memory")
#define PG8_WAIT_L(n) asm volatile("s_waitcnt lgkmcnt(" #n ")" ::: "memory")
#define PG8_BAR __builtin_amdgcn_s_barrier()
#define PG8_SCHED __builtin_amdgcn_sched_barrier(0)
    Unit cur, nxt; int ui = 0;
    if (!S.next(0, cur)) return;
    f32x4 acc[2][2][4][2];
#pragma unroll
    for (int a = 0; a < 2; ++a)
#pragma unroll
        for (int b = 0; b < 2; ++b)
#pragma unroll
            for (int m = 0; m < 4; ++m)
#pragma unroll
                for (int n = 0; n < 2; ++n) acc[a][b][m][n] = (f32x4){0.f, 0.f, 0.f, 0.f};
    bf16x8 At[4][2], B0[2][2], B1[2][2];
    const char* cA = (const char*)g.A + (size_t)cur.pm * tstep; const char* cB = (const char*)g.Bt + (size_t)cur.pn * tstep;
    S.a_ready(cur);
    if constexpr (SP2) {
        PG8_STAGE(PG8_SB(0, 0), cB, voffB); PG8_STAGE(PG8_SB(0, 1), cB + hstep, voffB); PG8_STAGE(PG8_SA(0, 0), cA, voffA); PG8_STAGE(PG8_SA(0, 1), cA + hstep, voffA);
        if (wr == 1) PG8_BAR;
        PG8_WAIT_V(2); PG8_BAR;
        PG8_STAGE(PG8_SB(1, 0), cB + kstep, voffB); PG8_STAGE(PG8_SA(1, 0), cA + kstep, voffA); PG8_STAGE(PG8_SB(1, 1), cB + hstep + kstep, voffB);
        PG8_WAIT_V(6); PG8_BAR;
    } else {
        PG8_STAGE(PG8_SB(0, 0), cB, voffB); PG8_STAGE(PG8_SA(0, 0), cA, voffA); PG8_STAGE(PG8_SB(0, 1), cB + hstep, voffB); PG8_STAGE(PG8_SA(0, 1), cA + hstep, voffA);
        if (wr == 1) PG8_BAR;
        PG8_WAIT_V(4); PG8_BAR;
        PG8_STAGE(PG8_SB(1, 0), cB + kstep, voffB); PG8_STAGE(PG8_SA(1, 0), cA + kstep, voffA); PG8_STAGE(PG8_SB(1, 1), cB + hstep + kstep, voffB);
        PG8_WAIT_V(6); PG8_BAR;
    }
    for (;;) {
        const bool has_next = S.next(ui + 1, nxt);
        const char* nA = has_next ? (const char*)g.A + (size_t)nxt.pm * tstep : cA; const char* nB = has_next ? (const char*)g.Bt + (size_t)nxt.pn * tstep : cB;
        for (int t = 0; t < nt; t += 2) {
            const bool last = (t == nt - 2);
            const char* a1 = cA + (size_t)(t + 1) * kstep;
            const char* a2 = last ? nA : cA + (size_t)(t + 2) * kstep; const char* b2 = last ? nB : cB + (size_t)(t + 2) * kstep;
            const char* a3 = a2 + kstep; const char* b3 = b2 + kstep;
            if (last && has_next) S.a_ready(nxt);
            if constexpr (SP2) {
            PG8_LDB(B0, 0, 0); PG8_LDB(B1, 0, 1); PG8_SCHED; PG8_LDA(At, 0, 0); PG8_STAGE(PG8_SA(1, 1), a1 + hstep, voffA);
            PG8_WAIT_V(8); PG8_WAIT_L(0); PG8_BAR; PG8_MMA(0, 0, At, B0); PG8_MMA(0, 1, At, B1); PG8_BAR; PG8_SCHED;
            PG8_LDA(At, 0, 1); PG8_STAGE(PG8_SB(0, 0), b2, voffB); PG8_STAGE(PG8_SB(0, 1), b2 + hstep, voffB); PG8_STAGE(PG8_SA(0, 0), a2, voffA);
            PG8_WAIT_V(8); PG8_WAIT_L(0); PG8_BAR; PG8_MMA(1, 0, At, B0); PG8_MMA(1, 1, At, B1); PG8_BAR; PG8_SCHED;
            PG8_LDB(B0, 1, 0); PG8_LDB(B1, 1, 1); PG8_SCHED; PG8_LDA(At, 1, 0); PG8_STAGE(PG8_SA(0, 1), a2 + hstep, voffA);
            PG8_WAIT_V(8); PG8_WAIT_L(0); PG8_BAR; PG8_MMA(0, 0, At, B0); PG8_MMA(0, 1, At, B1); PG8_BAR; PG8_SCHED;
            PG8_LDA(At, 1, 1); PG8_STAGE(PG8_SB(1, 0), b3, voffB); PG8_STAGE(PG8_SB(1, 1), b3 + hstep, voffB); PG8_STAGE(PG8_SA(1, 0), a3, voffA);
            PG8_WAIT_V(8); PG8_WAIT_L(0); PG8_BAR; PG8_MMA(1, 0, At, B0); PG8_MMA(1, 1, At, B1); PG8_BAR; PG8_SCHED;
            } else {
            PG8_LDB(B0, 0, 0); PG8_SCHED; PG8_LDA(At, 0, 0); PG8_STAGE(PG8_SA(1, 1), a1 + hstep, voffA);
            PG8_WAIT_L(8); PG8_BAR; PG8_WAIT_L(0); PG8_MMA(0, 0, At, B0); PG8_BAR; PG8_SCHED;
            PG8_LDB(B1, 0, 1); PG8_STAGE(PG8_SB(0, 0), b2, voffB);
            PG8_BAR; PG8_WAIT_L(0); PG8_MMA(0, 1, At, B1); PG8_BAR;
            PG8_LDA(At, 0, 1); PG8_STAGE(PG8_SA(0, 0), a2, voffA);
            PG8_BAR; PG8_WAIT_L(0); PG8_MMA(1, 0, At, B0); PG8_BAR; PG8_SCHED;
            PG8_STAGE(PG8_SB(0, 1), b2 + hstep, voffB);
            PG8_WAIT_V(6); PG8_BAR; PG8_MMA(1, 1, At, B1); PG8_BAR;
            PG8_LDB(B0, 1, 0); PG8_SCHED; PG8_LDA(At, 1, 0); PG8_STAGE(PG8_SA(0, 1), a2 + hstep, voffA);
            PG8_WAIT_L(8); PG8_BAR; PG8_WAIT_L(0); PG8_MMA(0, 0, At, B0); PG8_BAR; PG8_SCHED;
            PG8_LDB(B1, 1, 1); PG8_STAGE(PG8_SB(1, 0), b3, voffB);
            PG8_BAR; PG8_WAIT_L(0); PG8_MMA(0, 1, At, B1); PG8_BAR;
            PG8_LDA(At, 1, 1); PG8_STAGE(PG8_SA(1, 0), a3, voffA);
            PG8_BAR; PG8_WAIT_L(0); PG8_MMA(1, 0, At, B0); PG8_BAR; PG8_SCHED;
            PG8_STAGE(PG8_SB(1, 1), b3 + hstep, voffB);
            PG8_WAIT_V(6); PG8_BAR; PG8_MMA(1, 1, At, B1); PG8_BAR;
            }
        }
        if constexpr (ALIGN_EPI) { if (wr == 0) PG8_BAR; }
        if constexpr (!Epi::AFTER_DRAIN) { E(acc, cur, wr, wc, fr, fq); S.done(cur); }
        if (!has_next) break;
#pragma unroll
        for (int a = 0; a < 2; ++a)
#pragma unroll
            for (int b = 0; b < 2; ++b)
#pragma unroll
                for (int m = 0; m < 4; ++m)
#pragma unroll
                    for (int n = 0; n < 2; ++n) acc[a][b][m][n] = (f32x4){0.f, 0.f, 0.f, 0.f};
        cur = nxt; cA = nA; cB = nB; ++ui;
        if constexpr (ALIGN_EPI) { if (wr == 1) PG8_BAR; }
    }
    PG8_WAIT_V(0);
    if constexpr (!ALIGN_EPI) { if (wr == 0) PG8_BAR; }
    PG8_BAR;
    if constexpr (Epi::AFTER_DRAIN) { E.fused(acc, cur, wr, wc, fr, fq, lds, wid, lane); S.done(cur); }
#undef PG8_SA
#undef PG8_SB
#undef PG8_STAGE
#undef PG8_LDA
#undef PG8_LDB
#undef PG8_MMA
#undef PG8_WAIT_V
#undef PG8_WAIT_L
#undef PG8_BAR
#undef PG8_SCHED
}
}
#define LAS __attribute__((address_space(3)))
typedef unsigned short bf16;
typedef short bf16x8 __attribute__((ext_vector_type(8)));
typedef short s16x4 __attribute__((ext_vector_type(4)));
typedef float f32x4 __attribute__((ext_vector_type(4)));
typedef float f32x16 __attribute__((ext_vector_type(16)));
typedef unsigned u32x4 __attribute__((ext_vector_type(4)));
typedef unsigned u32x2 __attribute__((ext_vector_type(2)));
constexpr int NB = 16, SEQ = 2048, DM = 1024, MTOK = NB * SEQ, NH = 16, HD = 64, NG = 4;
constexpr int NSA_W = 2608, NSA_P = 2816, SB_P = 3072, DFF = 2816, DFF2 = 5632;
constexpr float LOG2E = 1.4426950408889634f, LN2 = 0.6931471805599453f;
constexpr size_t MiB = 1u << 20;
constexpr size_t WS_WNSA = 0, WS_WSB = 12 * MiB, WS_WOUT = 24 * MiB, WS_W13 = 32 * MiB, WS_W2 = 76 * MiB, WS_CW1 = 98 * MiB, WS_CW2 = 102 * MiB,
                 WS_CBIAS = 102 * MiB + 256 * 1024, WS_KC = 103 * MiB, WS_VCT = 104 * MiB, WS_SS = 105 * MiB, WS_GATES = 107 * MiB, WS_HB = 114 * MiB,
                 WS_O = 178 * MiB, WS_PROJ = 242 * MiB, WS_CTL = 436 * MiB, WS_END = 437 * MiB;
constexpr int LDS_BYTES = 147456 + 1024;
#ifndef TSEL
#define TSEL -1
#endif

struct Params { const float* in[15]; float* out; unsigned char* ws; int ph_lo, ph_hi; };

__device__ __forceinline__ unsigned f2bf(float f) { unsigned u = __builtin_bit_cast(unsigned, f); return (u + 0x7fffu + ((u >> 16) & 1u)) >> 16; }
__device__ __forceinline__ unsigned pk2(float lo, float hi) { return pg8::cvt_pk_bf16(lo, hi); }
__device__ __forceinline__ float wave_sum(float v) {
#pragma unroll
    for (int o = 1; o < 64; o <<= 1) v += __shfl_xor(v, o);
    return v;
}
__device__ __forceinline__ float swap32(float v) {
    const unsigned u = __builtin_bit_cast(unsigned, v);
    auto rr = __builtin_amdgcn_permlane32_swap(u, u, false, false);
    return __builtin_bit_cast(float, (threadIdx.x & 32) ? (unsigned)rr[0] : (unsigned)rr[1]);
}
__device__ __forceinline__ int crow(int r, int hi) { return (r & 3) + 8 * (r >> 2) + 4 * hi; }
__device__ __forceinline__ bf16x8 pack8(float a0, float a1, float a2, float a3, float a4, float a5, float a6, float a7) {
    u32x4 w; w.x = pk2(a0, a1); w.y = pk2(a2, a3); w.z = pk2(a4, a5); w.w = pk2(a6, a7); return __builtin_bit_cast(bf16x8, w);
}
typedef short v4i16_t __attribute__((ext_vector_type(4)));
__device__ __forceinline__ s16x4 vtr(const LAS unsigned char* p) { return __builtin_bit_cast(s16x4, __builtin_amdgcn_ds_read_tr16_b64_v4i16((LAS v4i16_t*)p)); }
#define MFMA32(a, b, c) __builtin_amdgcn_mfma_f32_32x32x16_bf16((a), (b), (c), 0, 0, 0)
#define MFMA16(a, b, c) __builtin_amdgcn_mfma_f32_16x16x32_bf16((a), (b), (c), 0, 0, 0)
#define LDS_FENCE() asm volatile("s_waitcnt lgkmcnt(0)" ::: "memory")

struct TrDesc { const float* W; int K, N; bf16* WT; int ldt; const float* ks; float qscale; int qcols; int mode; };
__device__ __forceinline__ void transpose_item(const TrDesc& d, LAS float* scr, int item, int lane) {
    const int nblk = (d.N + 31) >> 5, kb = item / nblk, nb = item - kb * nblk, k0 = 64 * kb, n0 = 32 * nb;
    const int nn = n0 + (lane & 31);
    float tv[32];
#pragma unroll
    for (int i = 0; i < 32; ++i) { const int kk = 2 * i + (lane >> 5); tv[i] = (nn < d.N) ? d.W[(size_t)(k0 + kk) * d.N + nn] : 0.f; }
    if (d.ks) {
#pragma unroll
        for (int i = 0; i < 32; ++i) tv[i] *= d.ks[k0 + 2 * i + (lane >> 5)];
    }
#pragma unroll
    for (int i = 0; i < 32; ++i) scr[(2 * i + (lane >> 5)) * 33 + (lane & 31)] = tv[i];
    LDS_FENCE();
    const int c = lane & 7;
#pragma unroll
    for (int j = 0; j < 4; ++j) {
        const int nl = (lane >> 3) + 8 * j, n = n0 + nl; const LAS float* s = scr + (8 * c) * 33 + nl;
        const float sc = (n < d.qcols) ? d.qscale : 1.0f;
        u32x4 o; o.x = pk2(s[0 * 33] * sc, s[1 * 33] * sc); o.y = pk2(s[2 * 33] * sc, s[3 * 33] * sc); o.z = pk2(s[4 * 33] * sc, s[5 * 33] * sc); o.w = pk2(s[6 * 33] * sc, s[7 * 33] * sc);
        const int row = d.mode == 0 ? n : (256 * (n >> 7) + (n & 127) + (d.mode == 2 ? 128 : 0));
        const size_t dst = (d.mode == 3) ? ((size_t)((k0 >> 6) * d.N + n) * 64 + 8 * c) : ((size_t)row * d.ldt + k0 + 8 * c);
        if (n < d.N) *(u32x4*)(d.WT + dst) = o;
    }
    LDS_FENCE();
}

__device__ __forceinline__ void prologue(const Params& p, LAS unsigned char* lds, int G) {
    int tid_ = threadIdx.x; asm volatile("" : "+v"(tid_)); const int tid = tid_, lane = tid & 63, wave = __builtin_amdgcn_readfirstlane(tid >> 6);
    LAS float* scr = (LAS float*)(lds + wave * 16384);
    const int gw = blockIdx.x * 8 + wave, NGW = G * 8;
    unsigned char* ws = p.ws;
    const float* mixg = p.in[1]; const float* ffng = p.in[2];
    { constexpr int IT = 16 * 82;
      for (int it = gw; it < 2 * IT; it += NGW) { const int j = it / IT, r = it - j * IT;
        TrDesc d{p.in[4] + (size_t)j * DM * NSA_W, DM, NSA_W, (bf16*)(ws + WS_WNSA) + (size_t)j * NSA_P * DM, DM, mixg + (2 * j) * DM, 0.125f * LOG2E, 1024, 0};
        transpose_item(d, scr, r, lane); } }
    { constexpr int IT = 16 * 96;
      for (int it = gw; it < 2 * IT; it += NGW) { const int j = it / IT, r = it - j * IT;
        TrDesc d{p.in[10] + (size_t)j * DM * SB_P, DM, SB_P, (bf16*)(ws + WS_WSB) + (size_t)j * SB_P * DM, DM, mixg + (2 * j + 1) * DM, 0.125f * LOG2E, 1024, 0};
        transpose_item(d, scr, r, lane); } }
    { constexpr int IT = 16 * 32;
      for (int it = gw; it < 4 * IT; it += NGW) { const int i = it / IT, r = it - i * IT;
        const float* W = ((i & 1) ? p.in[11] : p.in[9]) + (size_t)(i >> 1) * DM * DM;
        TrDesc d{W, DM, DM, (bf16*)(ws + WS_WOUT) + (size_t)i * DM * DM, DM, nullptr, 1.f, 0, 0};
        transpose_item(d, scr, r, lane); } }
    { constexpr int IT = 16 * 88;
      for (int it = gw; it < 8 * IT; it += NGW) { const int q = it / IT, r = it - q * IT, i = q & 3, which = q >> 2;
        TrDesc d{(which ? p.in[13] : p.in[12]) + (size_t)i * DM * DFF, DM, DFF, (bf16*)(ws + WS_W13) + (size_t)i * DFF2 * DM, DM, ffng + i * DM, 1.f, 0, which ? 2 : 1};
        transpose_item(d, scr, r, lane); } }
    { constexpr int IT = 44 * 32;
      for (int it = gw; it < 4 * IT; it += NGW) { const int i = it / IT, r = it - i * IT;
        TrDesc d{p.in[14] + (size_t)i * DFF * DM, DFF, DM, (bf16*)(ws + WS_W2) + (size_t)i * DM * DFF, DFF, nullptr, 1.f, 0, 0};
        transpose_item(d, scr, r, lane); } }
    { constexpr int IT = 32 * 8;
      for (int it = gw; it < 4 * IT; it += NGW) { const int q = it / IT, r = it - q * IT;
        TrDesc d{p.in[7] + (size_t)q * 2048 * 256, 2048, 256, (bf16*)(ws + WS_CW1) + (size_t)q * 256 * 2048, 2048, nullptr, 1.f, 0, 3};
        transpose_item(d, scr, r, lane); } }
    { constexpr int IT = 4 * 2;
      for (int it = gw; it < 4 * IT; it += NGW) { const int q = it / IT, r = it - q * IT;
        TrDesc d{p.in[8] + (size_t)q * 256 * 64, 256, 64, (bf16*)(ws + WS_CW2) + (size_t)q * 64 * 256, 256, nullptr, 1.f, 0, 0};
        transpose_item(d, scr, r, lane); } }
    { const float* x = p.in[0]; bf16* hb = (bf16*)(ws + WS_HB); float* ss = (float*)(ws + WS_SS);
      for (int m0 = gw * 4; m0 < MTOK; m0 += NGW * 4) {
        f32x4 v[4][4]; float sm[4];
#pragma unroll
        for (int q = 0; q < 4; ++q) { const f32x4* xr = (const f32x4*)(x + (size_t)(m0 + q) * DM) + lane;
#pragma unroll
          for (int j = 0; j < 4; ++j) v[q][j] = xr[64 * j]; }
#pragma unroll
        for (int q = 0; q < 4; ++q) { float t = 0.f;
#pragma unroll
          for (int j = 0; j < 4; ++j) t += (v[q][j][0] * v[q][j][0] + v[q][j][1] * v[q][j][1]) + (v[q][j][2] * v[q][j][2] + v[q][j][3] * v[q][j][3]);
          sm[q] = wave_sum(t); }
#pragma unroll
        for (int q = 0; q < 4; ++q) { u32x2* o8 = (u32x2*)(hb + (size_t)(m0 + q) * DM) + lane;
#pragma unroll
          for (int j = 0; j < 4; ++j) { u32x2 w; w.x = pk2(v[q][j][0], v[q][j][1]); w.y = pk2(v[q][j][2], v[q][j][3]); o8[64 * j] = w; } }
        { const int q = lane >> 4, c = lane & 15; const float tot = q == 0 ? sm[0] : q == 1 ? sm[1] : q == 2 ? sm[2] : sm[3]; ss[(size_t)(m0 + q) * 16 + c] = (c == 0) ? tot : 0.f; }
      } }
    { float* part = (float*)(ws + WS_CBIAS);
      for (int t = gw; t < 4 * 32; t += NGW) { const int q = t >> 5, kc = t & 31;
        const float* pe = p.in[6] + (size_t)q * 2048 + kc * 64; const float* W = p.in[7] + (size_t)q * 2048 * 256 + (size_t)kc * 64 * 256;
        f32x4 a = {0.f, 0.f, 0.f, 0.f};
#pragma unroll 16
        for (int k = 0; k < 64; ++k) { const float e = pe[k]; const f32x4 w = *((const f32x4*)(W + (size_t)k * 256) + lane); a += w * e; }
        *((f32x4*)(part + (size_t)(q * 32 + kc) * 256) + lane) = a; } }
    { const int gt = blockIdx.x * 512 + tid, NT = G * 512; constexpr int PER = (NSA_P - NSA_W) * DM * 2 / 16;
      for (int i = gt; i < 2 * PER; i += NT) { const int j = i / PER, r = i - j * PER;
        *((u32x4*)((bf16*)(ws + WS_WNSA) + (size_t)j * NSA_P * DM + (size_t)NSA_W * DM) + r) = (u32x4){0u, 0u, 0u, 0u}; } }
}

__device__ __forceinline__ float gelu_tanh(float v) {
    const float u = 0.7978845608028654f * (v + 0.044715f * v * v * v);
    return v * (1.0f - __builtin_amdgcn_rcpf(1.0f + __builtin_amdgcn_exp2f(2.8853900817779268f * u)));
}
__device__ __forceinline__ void compress_phase(const Params& p, LAS unsigned char* lds, int G, int layerj) {
    int tid_ = threadIdx.x; asm volatile("" : "+v"(tid_)); const int tid = tid_, lane = tid & 63, w = __builtin_amdgcn_readfirstlane(tid >> 6), l15 = lane & 15, l4 = lane >> 4;
    unsigned char* ws = p.ws;
    const bf16* proj = (const bf16*)(ws + WS_PROJ);
    LAS bf16* hid = (LAS bf16*)lds;
    for (int unit = blockIdx.x; unit < 256; unit += G) {
        const int kv = unit & 1, half = (unit >> 1) & 1, bg = unit >> 2, b = bg >> 2, g = bg & 3, n0 = half * 64;
        const int q = layerj * 2 + kv;
        const bf16* w1t = (const bf16*)(ws + WS_CW1) + (size_t)q * 256 * 2048;
        const bf16* w2t = (const bf16*)(ws + WS_CW2) + (size_t)q * 64 * 256;
        const float* part = (const float*)(ws + WS_CBIAS) + (size_t)q * 32 * 256;
        const int colbase = (kv ? 1280 : 1024) + g * 64;
        LAS unsigned char* abuf = lds + 36864;
        const bf16* asrc = proj + (size_t)(b * SEQ + 16 * (n0 + (tid >> 3))) * NSA_P + colbase + (tid & 7) * 8;
        const int awr = (tid >> 3) * 144 + (tid & 7) * 16;
        const LAS unsigned char* ard = abuf + l15 * 144 + l4 * 16;
        const bf16* bsrc = w1t + (size_t)(32 * w + l15) * 64 + l4 * 8;
        LAS float* biasl = (LAS float*)(lds + 64 * 264 * 2);
        if (tid < 256) { float pv[32];
#pragma unroll
            for (int kc = 0; kc < 32; ++kc) pv[kc] = part[kc * 256 + tid];
            float bsum = 0.f;
#pragma unroll
            for (int kc = 0; kc < 32; ++kc) bsum += pv[kc];
            biasl[tid] = bsum; }
        f32x4 acc[4][2];
#pragma unroll
        for (int rb = 0; rb < 4; ++rb)
#pragma unroll
            for (int cb = 0; cb < 2; ++cb) acc[rb][cb] = (f32x4){0.f, 0.f, 0.f, 0.f};
        u32x4 ga; bf16x8 fb[2][2][2];
#define CMP_LOADB(buf, l) do { _Pragma("unroll") for (int ks = 0; ks < 2; ++ks) _Pragma("unroll") for (int cb = 0; cb < 2; ++cb) \
            fb[buf][ks][cb] = *(const bf16x8*)(bsrc + (size_t)(l) * 256 * 64 + cb * 16 * 64 + ks * 32); } while (0)
#define CMP_STEP(buf, l) do { \
            bf16x8 fa[2][4]; \
            _Pragma("unroll") for (int ks = 0; ks < 2; ++ks) _Pragma("unroll") for (int rb = 0; rb < 4; ++rb) fa[ks][rb] = *(const LAS bf16x8*)(ard + (buf) * 9216 + rb * 16 * 144 + ks * 64); \
            _Pragma("unroll") for (int ks = 0; ks < 2; ++ks) _Pragma("unroll") for (int rb = 0; rb < 4; ++rb) _Pragma("unroll") for (int cb = 0; cb < 2; ++cb) \
                acc[rb][cb] = MFMA16(fa[ks][rb], fb[buf][ks][cb], acc[rb][cb]); \
            if ((l) + 1 < 32) *(LAS u32x4*)(abuf + ((buf) ^ 1) * 9216 + awr) = ga; \
            if ((l) + 2 < 32) { ga = *(const u32x4*)(asrc + (size_t)((l) + 2) * NSA_P); CMP_LOADB(buf, (l) + 2); } \
            __syncthreads(); } while (0)
        ga = *(const u32x4*)asrc; CMP_LOADB(0, 0);
        *(LAS u32x4*)(abuf + awr) = ga;
        ga = *(const u32x4*)(asrc + NSA_P); CMP_LOADB(1, 1);
        __syncthreads();
#pragma unroll 1
        for (int l = 0; l < 32; l += 2) { CMP_STEP(0, l); CMP_STEP(1, l + 1); }
#undef CMP_LOADB
#undef CMP_STEP
        __syncthreads();
#pragma unroll
        for (int cb = 0; cb < 2; ++cb) {
            const int col = 32 * w + 16 * cb + l15; const float bias = biasl[col];
#pragma unroll
            for (int rb = 0; rb < 4; ++rb)
#pragma unroll
                for (int j = 0; j < 4; ++j) hid[(16 * rb + l4 * 4 + j) * 264 + col] = (bf16)f2bf(gelu_tanh(acc[rb][cb][j] + bias));
        }
        __syncthreads();
        const int rb2 = w >> 1;
        f32x4 o2[2] = {(f32x4){0.f, 0.f, 0.f, 0.f}, (f32x4){0.f, 0.f, 0.f, 0.f}};
#pragma unroll
        for (int ks = 0; ks < 8; ++ks) {
            const bf16x8 a = *(const LAS bf16x8*)(hid + (16 * rb2 + l15) * 264 + ks * 32 + l4 * 8);
#pragma unroll
            for (int c2 = 0; c2 < 2; ++c2) {
                const int cb = 2 * (w & 1) + c2;
                const bf16x8 bb = *(const bf16x8*)(w2t + (size_t)(16 * cb + l15) * 256 + ks * 32 + l4 * 8);
                o2[c2] = MFMA16(a, bb, o2[c2]);
            }
        }
#pragma unroll
        for (int c2 = 0; c2 < 2; ++c2) {
            const int d = 16 * (2 * (w & 1) + c2) + l15, nb = n0 + 16 * rb2 + l4 * 4;
            float v[4];
#pragma unroll
            for (int j = 0; j < 4; ++j) v[j] = (nb + j == 127) ? 0.f : o2[c2][j];
            if (kv == 0) {
                bf16* kc = (bf16*)(ws + WS_KC) + (size_t)((b * 4 + g) * 128) * 64;
#pragma unroll
                for (int j = 0; j < 4; ++j) kc[(size_t)(nb + j) * 64 + d] = (bf16)f2bf(v[j]);
            } else {
                bf16* vct = (bf16*)(ws + WS_VCT) + (size_t)((b * 4 + g) * 64 + d) * 128 + nb;
                u32x2 wv; wv.x = pk2(v[0], v[1]); wv.y = pk2(v[2], v[3]); *(u32x2*)vct = wv;
            }
        }
        __syncthreads();
    }
}
#if TSEL >= 9
#define SECT_INIT() unsigned long long t_sect = __builtin_amdgcn_s_memrealtime()
#define SECT(k) do { if (blockIdx.x == 0 && tid == 0) { const unsigned long long t_now = __builtin_amdgcn_s_memrealtime(); ((LAS unsigned long long*)(lds + 147456 + 800))[k] += t_now - t_sect; t_sect = t_now; } } while (0)
#else
#define SECT_INIT() do {} while (0)
#define SECT(k) do {} while (0)
#endif
struct AttnState { float m, l; f32x16 o0, o1; };
constexpr int KV_BUF = 16384;
template <bool ELEM_MASK>
__device__ __forceinline__ void attn_tile(AttnState& st, const LAS unsigned char* qrl, const LAS unsigned char* kb, const LAS unsigned char* vb,
                                          float base, float slope2, int key0, int tq, int lo_q, int r32, int hi, int lane, bool first) {
    const LAS unsigned char* vp = vb + (4 * hi + ((lane & 15) >> 2)) * 64 + ((lane >> 4) & 1) * 32 + (lane & 3) * 8;
    const int rel = tq - key0 - 4 * hi, rello = lo_q - key0 - 4 * hi;
    f32x16 p0, p1;
    const float hbm = (base + slope2 * (float)(4 * hi)) - st.m;
#pragma unroll
    for (int r = 0; r < 16; ++r) { const int cr = (r & 3) + 8 * (r >> 2); p0[r] = hbm + slope2 * (float)cr; p1[r] = hbm + slope2 * (float)(cr + 32); }
#pragma unroll
    for (int d0 = 0; d0 < 4; ++d0) {
        const bf16x8 k0 = *(const LAS bf16x8*)(kb + (2 * d0 + hi) * 1024 + r32 * 16);
        const bf16x8 k1 = *(const LAS bf16x8*)(kb + (2 * d0 + hi) * 1024 + 512 + r32 * 16);
        const bf16x8 qf = *(const LAS bf16x8*)(qrl + d0 * 1024);
        p0 = MFMA32(k0, qf, p0); p1 = MFMA32(k1, qf, p1);
    }
    float mx = -INFINITY;
#pragma unroll
    for (int r = 0; r < 16; ++r) {
        if (ELEM_MASK) { const int cr = (r & 3) + 8 * (r >> 2); p0[r] = (cr <= rel && cr >= rello) ? p0[r] : -INFINITY; p1[r] = (cr + 32 <= rel && cr + 32 >= rello) ? p1[r] : -INFINITY; }
        mx = fmaxf(mx, fmaxf(p0[r], p1[r]));
    }
    mx = fmaxf(mx, swap32(mx));
    if (!first && __all(mx < -40.f)) return;
    if (first || __any(mx > 0.f)) {
        const float delta = first ? (mx > -1e30f ? mx : 0.f) : fmaxf(mx, 0.f);
        const float alpha = __builtin_amdgcn_exp2f(-delta);
        st.m += delta; st.l *= alpha;
#pragma unroll
        for (int r = 0; r < 16; ++r) { st.o0[r] *= alpha; st.o1[r] *= alpha; p0[r] -= delta; p1[r] -= delta; }
    }
    float rs = 0.f;
#pragma unroll
    for (int r = 0; r < 16; ++r) { p0[r] = __builtin_amdgcn_exp2f(p0[r]); p1[r] = __builtin_amdgcn_exp2f(p1[r]); rs += p0[r] + p1[r]; }
    st.l += rs;
    bf16x8 pb[4];
    pb[0] = pack8(p0[0], p0[1], p0[2], p0[3], p0[4], p0[5], p0[6], p0[7]);
    pb[1] = pack8(p0[8], p0[9], p0[10], p0[11], p0[12], p0[13], p0[14], p0[15]);
    pb[2] = pack8(p1[0], p1[1], p1[2], p1[3], p1[4], p1[5], p1[6], p1[7]);
    pb[3] = pack8(p1[8], p1[9], p1[10], p1[11], p1[12], p1[13], p1[14], p1[15]);
#pragma unroll
    for (int ks = 0; ks < 4; ++ks) {
        const s16x4 a0 = vtr(vp + ks * 1024), a1 = vtr(vp + ks * 1024 + 512), c0 = vtr(vp + 4096 + ks * 1024), c1 = vtr(vp + 4096 + ks * 1024 + 512);
        const bf16x8 v0 = __builtin_shufflevector(a0, a1, 0, 1, 2, 3, 4, 5, 6, 7);
        const bf16x8 v1 = __builtin_shufflevector(c0, c1, 0, 1, 2, 3, 4, 5, 6, 7);
        st.o0 = MFMA32(v0, pb[ks], st.o0); st.o1 = MFMA32(v1, pb[ks], st.o1);
    }
}

constexpr int CMPV_PITCH = 264, IMP_OFF = 34816, SELM_OFF = IMP_OFF + 4 * 64 * 33 * 4, OACC_OFF = SELM_OFF + 256;
__device__ __forceinline__ void nsa_tiles(AttnState& st, LAS unsigned char* lds, unsigned tilesS, unsigned tilesW, const bf16* kvbase  ,
                                          unsigned mysel, float slope2, int tq, int qt, int lane, int w, u32x4 kA, u32x4 vA, float gate_s  ) {
    asm volatile("" : "+v"(lane));
    const int r32 = lane & 31, hi = lane >> 5;
    const LAS unsigned char* qrl = lds + IMP_OFF + w * 4096 + lane * 16;
    const bf16* ksrc = kvbase + (size_t)lane * NSA_P + w * 8;
    const bf16* vsrc = kvbase + 256 + (size_t)(16 * (w & 3) + (lane >> 2)) * NSA_P + (w >> 2) * 32 + (lane & 3) * 8;
    const int sto = w * 1024 + lane * 16;
    unsigned remS = tilesS & ~(1u << qt), remW = tilesW;
#define NSA_POP(code) do { if (remS) { const int j_ = 31 - __builtin_clz(remS); remS &= ~(1u << j_); code = j_; } \
                          else if (remW) { const int j_ = 31 - __builtin_clz(remW); remW &= ~(1u << j_); code = 32 + j_; } else code = -1; } while (0)
#define NSA_FETCH(KR, VR, code) do { const int cc_ = (code) >= 0 ? (code) : qt;     \
        const size_t off_ = (size_t)(cc_ & 31) * 64 * NSA_P + (cc_ >> 5) * 512; KR = *(const u32x4*)(ksrc + off_); VR = *(const u32x4*)(vsrc + off_); } while (0)
    int c0 = qt, c1, c2; bool first = true;
    u32x4 kB, vB;
    NSA_POP(c1); NSA_FETCH(kB, vB, c1);
    *(LAS u32x4*)(lds + sto) = kA; *(LAS u32x4*)(lds + 8192 + sto) = vA;
    __syncthreads();
    int buf = 0;
#define NSA_STEP(KN, VN, KF, VF) do { \
        NSA_POP(c2); NSA_FETCH(KF, VF, c2); \
        { const int phase = c0 >> 5, j = c0 & 31; \
          const LAS unsigned char* kb = lds + buf * KV_BUF; const LAS unsigned char* vb = kb + 8192; \
          const bool selq = phase ? true : (((mysel >> j) & 1u) != 0u); \
          const float base = selq ? slope2 * (float)(64 * j - tq) : -INFINITY; \
          const int lo_q = phase ? tq - 511 : -(1 << 30); \
          if (j == qt || (phase && j == qt - 8)) attn_tile<true>(st, qrl, kb, vb, base, slope2, 64 * j, tq, lo_q, r32, hi, lane, first); \
          else attn_tile<false>(st, qrl, kb, vb, base, slope2, 64 * j, tq, lo_q, r32, hi, lane, false); } \
        { LAS unsigned char* nb = lds + (buf ^ 1) * KV_BUF; *(LAS u32x4*)(nb + sto) = KN; *(LAS u32x4*)(nb + 8192 + sto) = VN; }     \
        __syncthreads(); \
        first = false; \
        if (c1 >= 0 && (c1 >> 5) != (c0 >> 5)) {     \
            first = true; \
            LAS float* oacc2 = (LAS float*)(lds + OACC_OFF) + w * 2048 + lane; \
            const float lt = st.l + swap32(st.l); const float sc = gate_s / lt; \
            _Pragma("unroll") for (int r = 0; r < 16; ++r) { oacc2[r * 64] += st.o0[r] * sc; oacc2[(16 + r) * 64] += st.o1[r] * sc; } \
            st.m = 0.f; st.l = 0.f; \
            _Pragma("unroll") for (int r = 0; r < 16; ++r) { st.o0[r] = 0.f; st.o1[r] = 0.f; } } \
        c0 = c1; c1 = c2; buf ^= 1; } while (0)
    for (;;) {
        NSA_STEP(kB, vB, kA, vA);
        if (c0 < 0) break;
        NSA_STEP(kA, vA, kB, vB);
        if (c0 < 0) break;
    }
#undef NSA_POP
#undef NSA_FETCH
#undef NSA_STEP
}

__device__ __forceinline__ void nsa_attn_phase(const Params& p, LAS unsigned char* lds, int G) {
    int tid_ = threadIdx.x; asm volatile("" : "+v"(tid_)); const int tid = tid_, lane = tid & 63, w = __builtin_amdgcn_readfirstlane(tid >> 6), r32 = lane & 31, hi = lane >> 5, hh = w & 3, tb = w >> 2;
    unsigned char* ws = p.ws;
    const bf16* proj = (const bf16*)(ws + WS_PROJ);
    const float* gates = (const float*)(ws + WS_GATES);
    bf16* obuf = (bf16*)(ws + WS_O);
    LAS float* impw = (LAS float*)(lds + IMP_OFF);
    LAS unsigned* selm = (LAS unsigned*)(lds + SELM_OFF);
    for (int u = blockIdx.x; u < 2048; u += G) {
        SECT_INIT();
        int bg, qt;
        if (G == 256) { const int r = u >> 8, k = u & 255, c = k >> 6; bg = (k & 63) ^ (r & 3); qt = (r & 1) ? 4 * r + 3 - c : 4 * r + c; }
        else { bg = u & 63; qt = u >> 6; }
        const int b = bg >> 2, g = bg & 3, head = 4 * g + hh;
        const float slope2 = __builtin_amdgcn_exp2f(-0.5f * (float)(head + 1)) * LOG2E;
        const int tq = 64 * qt + 32 * tb + r32; const size_t row = (size_t)b * SEQ + tq;
        bf16x8 qr[4];
        { const bf16* qp = proj + row * NSA_P + head * 64 + hi * 8;
#pragma unroll
          for (int d0 = 0; d0 < 4; ++d0) qr[d0] = *(const bf16x8*)(qp + d0 * 16); }
        const float gate_c = gates[row * 48 + head], gate_s = gates[row * 48 + 16 + head], gate_w = gates[row * 48 + 32 + head];
        LAS float* oacc = (LAS float*)(lds + OACC_OFF) + w * 2048 + lane;
        const bf16* kvbase = proj + (size_t)b * SEQ * NSA_P + 1536 + g * 64;
        const u32x4 kreg0 = *(const u32x4*)(kvbase + (size_t)(64 * qt + lane) * NSA_P + w * 8);
        const u32x4 vreg0 = *(const u32x4*)(kvbase + 256 + (size_t)(64 * qt + 16 * (w & 3) + (lane >> 2)) * NSA_P + (w >> 2) * 32 + (lane & 3) * 8);
        {
            const int nct = (4 * qt + 3 + 31) >> 5;
            const bf16* kcb = (const bf16*)(ws + WS_KC) + (size_t)((b * 4 + g) * 128) * 64;
            const bf16* vctb = (const bf16*)(ws + WS_VCT) + (size_t)((b * 4 + g) * 64) * 128;
            {
                u32x4 kk[2], vv[2];
#pragma unroll
                for (int i = 0; i < 2; ++i) { const int id = tid + 512 * i; kk[i] = *(const u32x4*)(kcb + (size_t)(id >> 3) * 64 + (id & 7) * 8); vv[i] = *(const u32x4*)(vctb + (size_t)(id >> 4) * 128 + (id & 15) * 8); }
#pragma unroll
                for (int i = 0; i < 2; ++i) { const int id = tid + 512 * i;
                    *(LAS u32x4*)(lds + (id & 7) * 2048 + (id >> 3) * 16) = kk[i];
                    LAS unsigned char* vd = lds + 16384 + (id >> 4) * CMPV_PITCH + (id & 15) * 16;
                    *(LAS u32x2*)vd = (u32x2){vv[i].x, vv[i].y}; *(LAS u32x2*)(vd + 8) = (u32x2){vv[i].z, vv[i].w}; }
            }
            __syncthreads();
            const LAS unsigned char* kcl = lds + hi * 2048 + r32 * 16;
            const LAS unsigned char* vcl = lds + 16384 + r32 * CMPV_PITCH + 8 * hi;
            float m = -1e30f, l = 0.f;
#pragma unroll 1
            for (int t = 0; t < nct; ++t) {
                f32x16 a;
#pragma unroll
                for (int r = 0; r < 16; ++r) a[r] = 0.f;
#pragma unroll
                for (int d0 = 0; d0 < 4; ++d0) { const bf16x8 kf = *(const LAS bf16x8*)(kcl + d0 * 4096 + t * 512); a = MFMA32(kf, qr[d0], a); }
                float mx = -INFINITY;
#pragma unroll
                for (int r = 0; r < 16; ++r) { const int n = 32 * t + crow(r, hi), cend = 16 * n + 31; const float sv = a[r] + slope2 * (float)(cend - tq); a[r] = (cend <= tq) ? sv : -INFINITY; mx = fmaxf(mx, a[r]); }
                mx = fmaxf(mx, swap32(mx));
                const float mnew = fmaxf(m, mx); float rs = 0.f;
#pragma unroll
                for (int r = 0; r < 16; ++r) rs += __builtin_amdgcn_exp2f(a[r] - mnew);
                l = l * __builtin_amdgcn_exp2f(m - mnew) + rs; m = mnew;
            }
            l += swap32(l);
            const float inv = (l > 0.f) ? 1.0f / l : 0.f;
            LAS float* myimp = impw + (hh * 64 + tb * 32 + r32) * 33;
            float carry3 = 0.f;
            f32x16 out0, out1;
#pragma unroll
            for (int r = 0; r < 16; ++r) { out0[r] = 0.f; out1[r] = 0.f; }
#pragma unroll 1
            for (int t = 0; t < nct; ++t) {
                f32x16 a;
#pragma unroll
                for (int r = 0; r < 16; ++r) a[r] = 0.f;
#pragma unroll
                for (int d0 = 0; d0 < 4; ++d0) { const bf16x8 kf = *(const LAS bf16x8*)(kcl + d0 * 4096 + t * 512); a = MFMA32(kf, qr[d0], a); }
#pragma unroll
                for (int r = 0; r < 16; ++r) { const int n = 32 * t + crow(r, hi), cend = 16 * n + 31; const float sv = a[r] + slope2 * (float)(cend - tq); a[r] = (cend <= tq) ? __builtin_amdgcn_exp2f(sv - m) * inv : 0.f; }
                float rcv[4];
#pragma unroll
                for (int i = 0; i < 4; ++i) rcv[i] = swap32(a[4 * i + 3]);
#pragma unroll
                for (int i = 0; i < 4; ++i) {
                    const float own = 2.0f * (a[4 * i] + a[4 * i + 1] + a[4 * i + 2]) + a[4 * i + 3];
                    const float prev = hi ? rcv[i] : (i == 0 ? carry3 : rcv[i - 1]);
                    myimp[8 * t + 2 * i + hi] = own + prev;
                }
                carry3 = rcv[3];
#pragma unroll
                for (int ks = 0; ks < 2; ++ks) {
                    const bf16x8 pbk = pack8(a[8 * ks], a[8 * ks + 1], a[8 * ks + 2], a[8 * ks + 3], a[8 * ks + 4], a[8 * ks + 5], a[8 * ks + 6], a[8 * ks + 7]);
                    const LAS unsigned char* v0p = vcl + t * 64 + ks * 32;
                    const s16x4 a0 = *(const LAS s16x4*)v0p, a1 = *(const LAS s16x4*)(v0p + 16), c0 = *(const LAS s16x4*)(v0p + 32 * CMPV_PITCH), c1 = *(const LAS s16x4*)(v0p + 32 * CMPV_PITCH + 16);
                    const bf16x8 v0 = __builtin_shufflevector(a0, a1, 0, 1, 2, 3, 4, 5, 6, 7);
                    const bf16x8 v1 = __builtin_shufflevector(c0, c1, 0, 1, 2, 3, 4, 5, 6, 7);
                    out0 = MFMA32(v0, pbk, out0); out1 = MFMA32(v1, pbk, out1);
                }
            }
            const float gc = gate_c;
#pragma unroll
            for (int r = 0; r < 16; ++r) { oacc[r * 64] = out0[r] * gc; oacc[(16 + r) * 64] = out1[r] * gc; }
        }
        __syncthreads();
        SECT(0);
        for (int idx = tid; idx < 64 * 32; idx += 512) { const int q = idx >> 5, jj = idx & 31; LAS float* a = impw + q * 33 + jj;
            a[0] = (a[0] + a[64 * 33]) + (a[2 * 64 * 33] + a[3 * 64 * 33]); }
        __syncthreads();
        if (qt + 1 <= 8) { if (tid < 64) selm[tid] = (1u << (qt + 1)) - 1u; }
        else {
#pragma unroll 1
            for (int it = 0; it < 4; ++it) {
                const int q = 8 * w + 2 * it + hi, jj = r32;
                const LAS float* rowp = impw + q * 33;
                const float my = rowp[jj]; int cnt = 0;
                float rv[32];
#pragma unroll
                for (int j2 = 0; j2 < 32; ++j2) rv[j2] = rowp[j2];
#pragma unroll
                for (int j2 = 1; j2 < 31; ++j2) cnt += (j2 <= qt - 2 && (rv[j2] > my || (rv[j2] == my && j2 < jj))) ? 1 : 0;
                const bool forced = (jj == 0) || (jj == qt) || (jj == qt - 1);
                const bool cand = (jj >= 1) && (jj <= qt - 2);
                const bool sel = forced || (cand && cnt < 5);
                const unsigned long long bal = __ballot(sel);
                if (r32 == 0) selm[q] = hi ? (unsigned)(bal >> 32) : (unsigned)bal;
            }
        }
        __syncthreads();
        const unsigned mysel = selm[tb * 32 + r32];
        unsigned uni = selm[lane];
#pragma unroll
        for (int o = 1; o < 64; o <<= 1) uni |= __shfl_xor(uni, o);
        uni = __builtin_amdgcn_readfirstlane(uni);
        LAS unsigned char* qrl = lds + IMP_OFF + w * 4096 + lane * 16;
#pragma unroll
        for (int d0 = 0; d0 < 4; ++d0) *(LAS bf16x8*)(qrl + d0 * 1024) = qr[d0];
        SECT(1);
        {
            AttnState st; st.m = 0.f; st.l = 0.f;
#pragma unroll
            for (int r = 0; r < 16; ++r) { st.o0[r] = 0.f; st.o1[r] = 0.f; }
            const int jlo = qt >= 8 ? qt - 8 : 0;
            const unsigned tilesW = (unsigned)(((1ull << (qt + 1)) - 1ull) & ~((1ull << jlo) - 1ull));
            nsa_tiles(st, lds, uni, tilesW, kvbase, mysel, slope2, tq, qt, lane, w, kreg0, vreg0, gate_s);
            SECT(2);
            int l2 = lane; asm volatile("" : "+v"(l2)); const size_t row2 = (size_t)b * SEQ + 64 * qt + 32 * tb + (l2 & 31); LAS float* oacc2 = (LAS float*)(lds + OACC_OFF) + w * 2048 + l2;
            const float lt = st.l + swap32(st.l); const float sc = gate_w / lt;
            f32x16 out0, out1;
#pragma unroll
            for (int r = 0; r < 16; ++r) { out0[r] = oacc2[r * 64] + st.o0[r] * sc; out1[r] = oacc2[(16 + r) * 64] + st.o1[r] * sc; }
          bf16* op = obuf + row2 * DM + head * 64 + 4 * (l2 >> 5);
#pragma unroll
          for (int i = 0; i < 4; ++i) {
            u32x2 w0; w0.x = pk2(out0[4 * i], out0[4 * i + 1]); w0.y = pk2(out0[4 * i + 2], out0[4 * i + 3]); *(u32x2*)(op + 8 * i) = w0;
            u32x2 w1; w1.x = pk2(out1[4 * i], out1[4 * i + 1]); w1.y = pk2(out1[4 * i + 2], out1[4 * i + 3]); *(u32x2*)(op + 32 + 8 * i) = w1; } }
        SECT(3);
    }
}
__device__ __forceinline__ void sb_attn_phase(const Params& p, LAS unsigned char* lds, int G) {
    int tid_ = threadIdx.x; asm volatile("" : "+v"(tid_)); const int tid = tid_, lane = tid & 63, w = __builtin_amdgcn_readfirstlane(tid >> 6), r32 = lane & 31, hi = lane >> 5;
    unsigned char* ws = p.ws;
    const bf16* proj = (const bf16*)(ws + WS_PROJ);
    bf16* obuf = (bf16*)(ws + WS_O);
    LAS unsigned char* vl = lds + w * 4096;
    const LAS unsigned char* vp = vl + (4 * hi + ((lane & 15) >> 2)) * 64 + ((lane >> 4) & 1) * 32 + (lane & 3) * 8;
    const int gw = blockIdx.x * 8 + w, NGW = G * 8;
    for (int u = gw; u < NB * NH * 64; u += NGW) {
        const int qb = u & 63, head = (u >> 6) & 15, b = u >> 10;
        const int tq = 32 * qb + r32; const size_t row = (size_t)b * SEQ + tq;
        bf16x8 qr[4];
        { const bf16* qp = proj + row * SB_P + head * 64 + hi * 8;
#pragma unroll
          for (int d0 = 0; d0 < 4; ++d0) qr[d0] = *(const bf16x8*)(qp + d0 * 16); }
        const bf16* kbase = proj + (size_t)b * SEQ * SB_P + 1024 + head * 64;
        const bf16* vbase = proj + (size_t)b * SEQ * SB_P + 2048 + head * 64;
        f32x16 o0, o1;
#pragma unroll
        for (int r = 0; r < 16; ++r) { o0[r] = 0.f; o1[r] = 0.f; }
        float carry = 0.f;
        u32x4 vrA[4], vrB[4]; bf16x8 kfA[4], kfB[4];
#define SB_LOAD(VR, KF, kt_) do { const int key0_ = 32 * (kt_); \
            _Pragma("unroll") for (int i = 0; i < 4; ++i) { const int idx = i * 64 + lane, db = idx >> 7, key = (idx >> 2) & 31, c4 = idx & 3; \
                VR[i] = *(const u32x4*)(vbase + (size_t)(key0_ + key) * SB_P + 32 * db + 8 * c4); } \
            _Pragma("unroll") for (int d0 = 0; d0 < 4; ++d0) KF[d0] = *(const bf16x8*)(kbase + (size_t)(key0_ + r32) * SB_P + d0 * 16 + hi * 8); } while (0)
#define SB_TILE(VR, KF, kt_, DG) do { const int key0 = 32 * (kt_); \
            f32x16 z; \
            _Pragma("unroll") for (int r = 0; r < 16; ++r) z[r] = 0.f; \
            _Pragma("unroll") for (int d0 = 0; d0 < 4; ++d0) z = MFMA32(KF[d0], qr[d0], z); \
            LDS_FENCE(); \
            _Pragma("unroll") for (int i = 0; i < 4; ++i) *(LAS u32x4*)(vl + (i * 64 + lane) * 16) = VR[i]; \
              \
            float L[16]; \
            _Pragma("unroll") for (int r = 0; r < 16; ++r) { \
                const float zz = z[r]; \
                const float sp = fmaxf(zz, 0.f) + __builtin_amdgcn_logf(1.0f + __builtin_amdgcn_exp2f(-fabsf(zz))); \
                L[r] = (!(DG) || (key0 + crow(r, hi)) < tq) ? -sp : 0.f; } \
            float gsum[4], og[4], T[4]; \
            _Pragma("unroll") for (int i = 0; i < 4; ++i) { gsum[i] = (L[4 * i] + L[4 * i + 1]) + (L[4 * i + 2] + L[4 * i + 3]); og[i] = swap32(gsum[i]); T[i] = gsum[i] + og[i]; } \
            float R[4]; R[3] = 0.f; R[2] = T[3]; R[1] = T[3] + T[2]; R[0] = R[1] + T[1]; \
            float a[16]; \
            _Pragma("unroll") for (int i = 0; i < 4; ++i) { \
                const float A = carry + R[i] + (hi ? 0.f : og[i]); \
                const float s3 = A, s2 = s3 + L[4 * i + 3], s1 = s2 + L[4 * i + 2], s0 = s1 + L[4 * i + 1]; \
                const float suf[4] = {s0, s1, s2, s3}; \
                _Pragma("unroll") for (int e4 = 0; e4 < 4; ++e4) { const int r = 4 * i + e4; const float ev = __builtin_amdgcn_exp2f(z[r] + L[r] + suf[e4]); \
                    a[r] = (!(DG) || (key0 + crow(r, hi)) < tq) ? ev : 0.f; } } \
            carry += R[0] + T[0]; \
            const bf16x8 pb0 = pack8(a[0], a[1], a[2], a[3], a[4], a[5], a[6], a[7]), pb1 = pack8(a[8], a[9], a[10], a[11], a[12], a[13], a[14], a[15]); \
            LDS_FENCE(); \
            _Pragma("unroll") for (int ks = 0; ks < 2; ++ks) { \
                const s16x4 a0 = vtr(vp + ks * 1024), a1 = vtr(vp + ks * 1024 + 512), c0 = vtr(vp + 2048 + ks * 1024), c1 = vtr(vp + 2048 + ks * 1024 + 512); \
                const bf16x8 v0 = __builtin_shufflevector(a0, a1, 0, 1, 2, 3, 4, 5, 6, 7); \
                const bf16x8 v1 = __builtin_shufflevector(c0, c1, 0, 1, 2, 3, 4, 5, 6, 7); \
                o0 = MFMA32(v0, ks ? pb1 : pb0, o0); o1 = MFMA32(v1, ks ? pb1 : pb0, o1); } } while (0)
#define SB_DONE(kt_) ((kt_) == 0 || __all(carry < -30.0f))
        SB_LOAD(vrA, kfA, qb);
        if (qb > 0) SB_LOAD(vrB, kfB, qb - 1);
        SB_TILE(vrA, kfA, qb, 1);
        if (!SB_DONE(qb)) {
            for (int kt = qb - 1;;) {
                if (kt > 0) SB_LOAD(vrA, kfA, kt - 1);
                SB_TILE(vrB, kfB, kt, 0);
                if (SB_DONE(kt)) break;
                --kt;
                if (kt > 0) SB_LOAD(vrB, kfB, kt - 1);
                SB_TILE(vrA, kfA, kt, 0);
                if (SB_DONE(kt)) break;
                --kt;
            }
        }
#undef SB_DONE
#undef SB_LOAD
#undef SB_TILE
        LDS_FENCE();
        { bf16* op = obuf + row * DM + head * 64 + 4 * hi;
#pragma unroll
          for (int i = 0; i < 4; ++i) {
            u32x2 w0; w0.x = pk2(o0[4 * i], o0[4 * i + 1]); w0.y = pk2(o0[4 * i + 2], o0[4 * i + 3]); *(u32x2*)(op + 8 * i) = w0;
            u32x2 w1; w1.x = pk2(o1[4 * i], o1[4 * i + 1]); w1.y = pk2(o1[4 * i + 2], o1[4 * i + 3]); *(u32x2*)(op + 32 + 8 * i) = w1; } }
    }
}

__device__ __forceinline__ void final_norm_phase(const Params& p, int G) {
    int tid_ = threadIdx.x; asm volatile("" : "+v"(tid_));
    const int lane = tid_ & 63, gw = blockIdx.x * 8 + __builtin_amdgcn_readfirstlane(tid_ >> 6), NGW = G * 8;
    const float* ss = (const float*)(p.ws + WS_SS); const float* g = p.in[3]; const bf16* hb = (const bf16*)(p.ws + WS_HB);
    f32x4 gv[4];
#pragma unroll
    for (int j = 0; j < 4; ++j) gv[j] = *((const f32x4*)g + lane + 64 * j);
    for (int m0 = gw * 2; m0 < MTOK; m0 += NGW * 2) {
        u32x2 hv[2][4]; float rs[2];
#pragma unroll
        for (int q = 0; q < 2; ++q) { rs[q] = pg8::row_rstd(ss, m0 + q);
#pragma unroll
          for (int j = 0; j < 4; ++j) hv[q][j] = *((const u32x2*)(hb + (size_t)(m0 + q) * DM) + lane + 64 * j); }
#pragma unroll
        for (int q = 0; q < 2; ++q) { f32x4* xr = (f32x4*)(p.out + (size_t)(m0 + q) * DM) + lane;
#pragma unroll
          for (int j = 0; j < 4; ++j) { f32x4 v; v[0] = __builtin_bit_cast(float, hv[q][j].x << 16); v[1] = __builtin_bit_cast(float, hv[q][j].x & 0xffff0000u);
            v[2] = __builtin_bit_cast(float, hv[q][j].y << 16); v[3] = __builtin_bit_cast(float, hv[q][j].y & 0xffff0000u); xr[64 * j] = v * rs[q] * gv[j]; } }
    }
}

#define XB_TMO      128
#define XB_XCNT(j)  (256  + 64 * (j))
#define XB_XSUB(j)  (1280 + 64 * (j))
#define XB_XGEN(j)  (2304 + 64 * (j))
#define XB_TOP      3328
#define XB_TOPGEN   3392
#define XCD_BAR_WORDS 3456
#define XB_SPIN_CAP (1u << 18)

__device__ __forceinline__ unsigned xb_ld(unsigned* p)              { return __hip_atomic_load(p, __ATOMIC_RELAXED, __HIP_MEMORY_SCOPE_AGENT); }
__device__ __forceinline__ unsigned xb_add(unsigned* p, unsigned v) { return __hip_atomic_fetch_add(p, v, __ATOMIC_RELAXED, __HIP_MEMORY_SCOPE_AGENT); }
__device__ __forceinline__ unsigned xb_xcc_id() { return (unsigned)__builtin_amdgcn_s_getreg((3 << 11) | 20) & 0xFu; }
#define XB_SPIN(cond, bar) do { unsigned _sp = 0; while (cond) { __builtin_amdgcn_s_sleep(1); \
    if ((++_sp & 255u) == 0u) { if (xb_ld(&(bar)[XB_TMO])) break; if (_sp > XB_SPIN_CAP) { atomicAdd(&(bar)[XB_TMO], 1u); break; } } } } while (0)

struct XcdBarrier {
    unsigned* bar; unsigned x;
    volatile LAS unsigned* st;
};

__device__ __forceinline__ XcdBarrier xcd_barrier_post(unsigned* bar, volatile LAS unsigned* st) {
    XcdBarrier b; b.bar = bar; b.x = xb_xcc_id(); b.st = st;
    if (threadIdx.x == 0) (void)xb_add(&bar[XB_XCNT(b.x)], 1u);
    return b;
}
__device__ __forceinline__ void xcd_barrier_complete(unsigned* bar, unsigned x, unsigned& nloc, unsigned& nx) {
    const unsigned G = gridDim.x * gridDim.y * gridDim.z;
    unsigned sum, cnt, mine, sp = 0u;
    for (;;) {
        sum = 0u; cnt = 0u; mine = 0u;
#pragma unroll
        for (unsigned j = 0; j < 16; ++j) { const unsigned c = xb_ld(&bar[XB_XCNT(j)]); sum += c; cnt += (c > 0u) ? 1u : 0u; mine = (j == x) ? c : mine; }
        if (sum == G) break;
        __builtin_amdgcn_s_sleep(1);
        if ((++sp & 255u) == 0u) { if (xb_ld(&bar[XB_TMO])) break; if (sp > XB_SPIN_CAP) { atomicAdd(&bar[XB_TMO], 1u); break; } }
    }
    nloc = mine > 0u ? mine : 1u; nx = cnt > 0u ? cnt : 1u;
}

__device__ __forceinline__ void xcd_barrier(const XcdBarrier& b) {
    asm volatile("s_waitcnt vmcnt(0)" ::: "memory");
    __syncthreads();
    if (threadIdx.x == 0) {
        unsigned* bar = b.bar;
        __builtin_amdgcn_s_waitcnt(0);
        unsigned nloc = b.st[0], nx = b.st[1];
        if (nloc == 0u) { xcd_barrier_complete(bar, b.x, nloc, nx); b.st[0] = nloc; b.st[1] = nx; }
        const unsigned old = xb_add(&bar[XB_XSUB(b.x)], 1u);
        const unsigned gen = old / nloc;
        if (old + 1u == (gen + 1u) * nloc) {
            __builtin_amdgcn_fence(__ATOMIC_RELEASE, "agent");
            asm volatile("s_waitcnt vmcnt(0)" ::: "memory");
            const unsigned og = xb_add(&bar[XB_TOP], 1u);
            const unsigned tg = og / nx;
            if (og + 1u == (tg + 1u) * nx) xb_add(&bar[XB_TOPGEN], 1u);
            else XB_SPIN(xb_ld(&bar[XB_TOPGEN]) == tg, bar);
            __builtin_amdgcn_fence(__ATOMIC_ACQUIRE, "agent");
            xb_add(&bar[XB_XGEN(b.x)], 1u);
            asm volatile("s_waitcnt vmcnt(0)" ::: "memory");
        } else {
            XB_SPIN(xb_ld(&bar[XB_XGEN(b.x)]) == gen, bar);
            __builtin_amdgcn_fence(__ATOMIC_ACQUIRE, "agent");
            asm volatile("s_waitcnt vmcnt(0)" ::: "memory");
        }
    }
    __syncthreads();
}

__global__ void __launch_bounds__(512, 2) mega(Params p) {
    extern __shared__ __attribute__((aligned(16))) unsigned char lds_raw[];
    LAS unsigned char* lds = (LAS unsigned char*)lds_raw;
    cg::grid_group grid = cg::this_grid();
    const int G = gridDim.x;
    unsigned char* ws = p.ws;
    bf16* hb = (bf16*)(ws + WS_HB); bf16* proj = (bf16*)(ws + WS_PROJ); bf16* obuf = (bf16*)(ws + WS_O);
    float* ss = (float*)(ws + WS_SS); float* gates = (float*)(ws + WS_GATES);
    volatile LAS unsigned* bst = (volatile LAS unsigned*)(lds + 147456 + 768);
    if (threadIdx.x < 2) bst[threadIdx.x] = 0u;
    if (threadIdx.x < 8) ((LAS unsigned long long*)(lds + 147456 + 800))[threadIdx.x] = 0ull;
    __syncthreads();
    XcdBarrier bar = xcd_barrier_post((unsigned*)(ws + WS_CTL), bst);
    int ph = 0;
    LAS unsigned long long* tsl = (LAS unsigned long long*)(lds + 147456);
    LAS int* kindl = (LAS int*)(lds + 147456 + 512);
    const bool stamper = (TSEL >= 0) && blockIdx.x == 0 && threadIdx.x == 0;
    if (stamper) tsl[0] = __builtin_amdgcn_s_memrealtime();
#define PHASE_ON (ph >= p.ph_lo && ph < p.ph_hi)
#define PHASE_END(kind) do { if (ph >= p.ph_lo && ph + 1 < p.ph_hi) { if (ph == 0) grid.sync(); else xcd_barrier(bar); } if (stamper) { tsl[ph + 1] = __builtin_amdgcn_s_memrealtime(); kindl[ph] = (kind); } ++ph; } while (0)
    if (PHASE_ON) prologue(p, lds, G);
    PHASE_END(0);
#pragma unroll 1
    for (int i = 0; i < 4; ++i) {
        const bool nsa = !(i & 1); const int j = i >> 1;
        if (PHASE_ON) {
            const bf16* Wt = nsa ? (const bf16*)(ws + WS_WNSA) + (size_t)j * NSA_P * DM : (const bf16*)(ws + WS_WSB) + (size_t)j * SB_P * DM;
            const int N = nsa ? NSA_P : SB_P;
            pg8::Gemm g{hb, Wt, MTOK, N, DM}; pg8::StaticOrder S; S.init(MTOK, N, G, (int)blockIdx.x);
            pg8::EpiProj E{proj, N, ss, p.in[5] + j * 48, gates, nsa ? 2560 : (1 << 30)};
            pg8::gemm_phase<pg8::EpiProj, pg8::StaticOrder, true, true>(lds, g, S, E);
        }
        PHASE_END(1);
        if (nsa) {
            if (PHASE_ON) compress_phase(p, lds, G, j);
            PHASE_END(2);
            if (PHASE_ON) nsa_attn_phase(p, lds, G);
            PHASE_END(3);
        } else {
            if (PHASE_ON) sb_attn_phase(p, lds, G);
            PHASE_END(4);
        }
#pragma unroll 1
        for (int s = 0; s < 2; ++s) {
            if (PHASE_ON) {
                const bf16* A = s == 0 ? obuf : proj;
                const bf16* Wt = s == 0 ? (const bf16*)(ws + WS_WOUT) + (size_t)i * DM * DM : (const bf16*)(ws + WS_W2) + (size_t)i * DM * DFF;
                pg8::Gemm g{A, Wt, MTOK, DM, s == 0 ? DM : DFF}; pg8::StaticOrder S; S.init(MTOK, DM, G, (int)blockIdx.x);
                pg8::EpiResid E{hb, ss};
                pg8::gemm_phase<pg8::EpiResid, pg8::StaticOrder, true, true>(lds, g, S, E);
            }
            PHASE_END(5);
            if (s == 0) {
                if (PHASE_ON) {
                    pg8::Gemm g{hb, (const bf16*)(ws + WS_W13) + (size_t)i * DFF2 * DM, MTOK, DFF2, DM}; pg8::StaticOrder S; S.init(MTOK, DFF2, G, (int)blockIdx.x);
                    pg8::EpiSwiGLU E{proj, ss};
                    pg8::gemm_phase<pg8::EpiSwiGLU, pg8::StaticOrder, true, true>(lds, g, S, E);
                }
                PHASE_END(6);
            }
        }
    }
    if (TSEL == 8) { for (int q = 0; q < 10; ++q) { PHASE_END(8); } }
    if (PHASE_ON) final_norm_phase(p, G);
    if (TSEL >= 0) {
        grid.sync();
        if (stamper) { tsl[ph + 1] = __builtin_amdgcn_s_memrealtime(); kindl[ph] = 7; }
        if (blockIdx.x == 0) {
            __syncthreads();
            unsigned long long T = 0;
            for (int k = 0; k <= ph; ++k) if (kindl[k] == TSEL) T += tsl[k + 1] - tsl[k];
            if (TSEL >= 9) T = ((LAS unsigned long long*)(lds + 147456 + 800))[TSEL - 9];
            const int K = (int)(T / 100);
            for (int r = threadIdx.x; r < K && r < MTOK; r += 512) p.out[(size_t)r * DM + 7] += 0.1f;
        }
    }
}

extern "C" void kernel_launch(void* const* d_in, const int* in_sizes, int n_in, void* d_out, int out_size, void* d_ws, size_t ws_size, hipStream_t stream) {
    static int grid = 0;
    if (grid == 0) {
        if (n_in != 15 || out_size != MTOK * DM || ws_size < WS_END) { fprintf(stderr, "kernel_launch: unexpected shapes (n_in %d out %d ws %zu)\n", n_in, out_size, ws_size); grid = -1; return; }
        int dev = 0, cus = 0, per_cu = 0;
        if (hipGetDevice(&dev) != hipSuccess || hipDeviceGetAttribute(&cus, hipDeviceAttributeMultiprocessorCount, dev) != hipSuccess) { grid = -1; return; }
        if (hipFuncSetAttribute((const void*)mega, hipFuncAttributeMaxDynamicSharedMemorySize, LDS_BYTES) != hipSuccess) { fprintf(stderr, "hipFuncSetAttribute failed\n"); grid = -1; return; }
        if (hipOccupancyMaxActiveBlocksPerMultiprocessor(&per_cu, mega, 512, LDS_BYTES) != hipSuccess || per_cu < 1) { fprintf(stderr, "occupancy query failed\n"); grid = -1; return; }
        grid = cus;
    }
    if (grid <= 0) return;
    Params p{};
    for (int i = 0; i < 15; ++i) p.in[i] = (const float*)d_in[i];
    p.out = (float*)d_out; p.ws = (unsigned char*)d_ws; p.ph_lo = 0; p.ph_hi = 1000;
    if (hipMemsetAsync((unsigned char*)d_ws + WS_CTL, 0, XCD_BAR_WORDS * sizeof(unsigned), stream) != hipSuccess) { fprintf(stderr, "memset failed\n"); return; }
    void* args[] = {&p};
    hipError_t e = hipLaunchCooperativeKernel((void*)mega, dim3(grid), dim3(512), args, LDS_BYTES, stream);
    if (e != hipSuccess) fprintf(stderr, "cooperative launch failed: %s (grid %d)\n", hipGetErrorString(e), grid);
}
```

```cpp
#include <hip/hip_runtime.h>
#include <hip/hip_cooperative_groups.h>
#include <cstdio>
#include <cstdint>
#include <cmath>
namespace cg = cooperative_groups;
namespace pg8 {
#define PG8_LAS __attribute__((address_space(3)))
typedef unsigned short bf16_t;
typedef short bf16x8 __attribute__((ext_vector_type(8)));
typedef float f32x4 __attribute__((ext_vector_type(4)));
typedef unsigned u32x4 __attribute__((ext_vector_type(4)));
constexpr int BM = 256, BK = 64, HALF = 128, HTB = HALF * BK * 2  , STAGE_BYTES = 8 * HTB, NXCD = 8, WGM = 8;

__host__ __device__ __forceinline__ int lds_byte(int r, int c) { const int st = (r >> 4) * 2 + (c >> 5), rr = r & 15, cc = c & 31, ob = rr * 64 + cc * 2; return st * 1024 + (ob ^ (((ob >> 9) & 1) << 5)); }
__host__ __device__ __forceinline__ void stage_rc(int b, int& R, int& C) { const int st = b / 1024, sb = b % 1024, swz = sb ^ (((sb >> 9) & 1) << 5); R = (st >> 1) * 16 + swz / 64; C = (st & 1) * 32 + (swz % 64) / 2; }
__host__ __device__ __forceinline__ int perm32(int rho) { const int n = rho >> 4, i = rho & 15; return 8 * (i >> 2) + 4 * n + (i & 3); }

struct Unit { int pm, pn; };
struct Gemm { const bf16_t* A; const bf16_t* Bt; int M, N, K; };

struct StaticOrder {
    int nM, nN, nwg, G, c;
    __host__ __device__ void init(int M, int N, int G_, int c_) { nM = M / BM; nN = N / BM; nwg = nM * nN; G = G_; c = c_; }
    __host__ __device__ bool next(int i, Unit& u) const {
        const long L = (long)i * G + c; if (L >= nwg) return false;
        int wgid = (int)L; { const int q = nwg / NXCD, r = nwg % NXCD, xcd = wgid % NXCD, off = wgid / NXCD; wgid = (xcd < r ? xcd * (q + 1) : r * (q + 1) + (xcd - r) * q) + off; }
        const int nig = WGM * nN, gid = wgid / nig, fm = gid * WGM, gsz = (nM - fm) < WGM ? (nM - fm) : WGM;
        u.pm = fm + ((wgid % nig) % gsz); u.pn = (wgid % nig) / gsz; return true;
    }
    __device__ __forceinline__ void a_ready(const Unit&) const {}
    __device__ __forceinline__ void done(const Unit&) const {}
};

__device__ __forceinline__ unsigned cvt_pk_bf16(float lo, float hi) { unsigned r; asm volatile("v_cvt_pk_bf16_f32 %0, %1, %2" : "=v"(r) : "v"(lo), "v"(hi)); return r; }
typedef unsigned u32x4 __attribute__((ext_vector_type(4)));
typedef float f32x2 __attribute__((ext_vector_type(2)));
__device__ __forceinline__ float row_rstd(const float* ss, int row) {
    const f32x4* p = (const f32x4*)(ss + (size_t)row * 16);
    const f32x4 a = p[0], b = p[1], c = p[2], d = p[3];
    const float s = (((a[0] + a[1]) + (a[2] + a[3])) + ((b[0] + b[1]) + (b[2] + b[3]))) + (((c[0] + c[1]) + (c[2] + c[3])) + ((d[0] + d[1]) + (d[2] + d[3])));
    return rsqrtf(s * (1.0f / 1024.0f) + 1e-6f);
}
__device__ __forceinline__ void rows_rstd8(const float* ss, int row0, int fq, float (&rs)[2][4]) {
    f32x4 v[2][4];
#pragma unroll
    for (int ai = 0; ai < 2; ++ai)
#pragma unroll
        for (int m = 0; m < 4; ++m) v[ai][m] = *(const f32x4*)(ss + (size_t)(row0 + ai * HALF + m * 16) * 16 + 4 * fq);
#pragma unroll
    for (int ai = 0; ai < 2; ++ai)
#pragma unroll
        for (int m = 0; m < 4; ++m) { float t = (v[ai][m][0] + v[ai][m][1]) + (v[ai][m][2] + v[ai][m][3]); t += __shfl_xor(t, 16); t += __shfl_xor(t, 32); rs[ai][m] = rsqrtf(t * (1.0f / 1024.0f) + 1e-6f); }
}
struct EpiProj {
    static constexpr bool PERM = true, AFTER_DRAIN = false;
    bf16_t* O; int ldc; const float* ss; const float* gate_b; float* gates; int gate_col0;
    __device__ __forceinline__ void operator()(const f32x4 (&acc)[2][2][4][2], const Unit& u, int wr, int wc, int fr, int fq) const {
        const int row0 = u.pm * BM + wr * 64 + fr, col0 = u.pn * BM + wc * 32 + 8 * fq;
        float rsv[2][4]; rows_rstd8(ss, row0, fq, rsv);
#pragma unroll
        for (int ai = 0; ai < 2; ++ai)
#pragma unroll
            for (int m = 0; m < 4; ++m) {
                const int row = row0 + ai * HALF + m * 16; const float rs = rsv[ai][m];
#pragma unroll
                for (int bj = 0; bj < 2; ++bj) {
                    const int col = col0 + bj * HALF;
                    const f32x4 v0 = acc[ai][bj][m][0] * rs, v1 = acc[ai][bj][m][1] * rs;
                    if (col >= gate_col0) {
                        if (col < gate_col0 + 48) {
                            const int gc = col - gate_col0; const f32x4 b0 = *(const f32x4*)(gate_b + gc), b1 = *(const f32x4*)(gate_b + gc + 4);
                            f32x4 g0, g1;
#pragma unroll
                            for (int k = 0; k < 4; ++k) { g0[k] = 1.0f / (1.0f + __expf(-(v0[k] + b0[k]))); g1[k] = 1.0f / (1.0f + __expf(-(v1[k] + b1[k]))); }
                            *(f32x4*)(gates + (size_t)row * 48 + gc) = g0; *(f32x4*)(gates + (size_t)row * 48 + gc + 4) = g1;
                        }
                    } else {
                        u32x4 w; w.x = cvt_pk_bf16(v0[0], v0[1]); w.y = cvt_pk_bf16(v0[2], v0[3]); w.z = cvt_pk_bf16(v1[0], v1[1]); w.w = cvt_pk_bf16(v1[2], v1[3]);
                        *(u32x4*)(O + (size_t)row * ldc + col) = w;
                    }
                }
            }
    }
};
struct EpiResid {
    static constexpr bool PERM = true, AFTER_DRAIN = false;
    bf16_t* hb; float* ss;
    __device__ __forceinline__ void operator()(const f32x4 (&acc)[2][2][4][2], const Unit& u, int wr, int wc, int fr, int fq) const {
        const int row0 = u.pm * BM + wr * 64 + fr, col0 = u.pn * BM + wc * 32 + 8 * fq;
        u32x4 bq[2][4][2];
#pragma unroll
        for (int ai = 0; ai < 2; ++ai)
#pragma unroll
            for (int m = 0; m < 4; ++m)
#pragma unroll
                for (int bj = 0; bj < 2; ++bj) if (ai == 0 || m < 2) bq[ai][m][bj] = *(const u32x4*)(hb + (size_t)(row0 + ai * HALF + m * 16) * 1024 + col0 + bj * HALF);
#pragma unroll
        for (int ai = 0; ai < 2; ++ai)
#pragma unroll
            for (int m = 0; m < 4; ++m) {
                if (ai == 1 && m == 0) {
#pragma unroll
                    for (int m2 = 2; m2 < 4; ++m2)
#pragma unroll
                        for (int bj = 0; bj < 2; ++bj) bq[1][m2][bj] = *(const u32x4*)(hb + (size_t)(row0 + HALF + m2 * 16) * 1024 + col0 + bj * HALF);
                }
                const int row = row0 + ai * HALF + m * 16; float sq = 0.f;
#pragma unroll
                for (int bj = 0; bj < 2; ++bj) {
                    const u32x4 b = bq[ai][m][bj];
                    f32x4 v0, v1;
                    v0[0] = __builtin_bit_cast(float, b.x << 16) + acc[ai][bj][m][0][0]; v0[1] = __builtin_bit_cast(float, b.x & 0xffff0000u) + acc[ai][bj][m][0][1];
                    v0[2] = __builtin_bit_cast(float, b.y << 16) + acc[ai][bj][m][0][2]; v0[3] = __builtin_bit_cast(float, b.y & 0xffff0000u) + acc[ai][bj][m][0][3];
                    v1[0] = __builtin_bit_cast(float, b.z << 16) + acc[ai][bj][m][1][0]; v1[1] = __builtin_bit_cast(float, b.z & 0xffff0000u) + acc[ai][bj][m][1][1];
                    v1[2] = __builtin_bit_cast(float, b.w << 16) + acc[ai][bj][m][1][2]; v1[3] = __builtin_bit_cast(float, b.w & 0xffff0000u) + acc[ai][bj][m][1][3];
                    u32x4 w; w.x = cvt_pk_bf16(v0[0], v0[1]); w.y = cvt_pk_bf16(v0[2], v0[3]); w.z = cvt_pk_bf16(v1[0], v1[1]); w.w = cvt_pk_bf16(v1[2], v1[3]);
                    *(u32x4*)(hb + (size_t)row * 1024 + col0 + bj * HALF) = w;
                    sq += ((v0[0] * v0[0] + v0[1] * v0[1]) + (v0[2] * v0[2] + v0[3] * v0[3])) + ((v1[0] * v1[0] + v1[1] * v1[1]) + (v1[2] * v1[2] + v1[3] * v1[3]));
                }
                sq += __shfl_xor(sq, 16); sq += __shfl_xor(sq, 32);
                if (fq == 0) ss[(size_t)row * 16 + u.pn * 4 + wc] = sq;
            }
    }
};
struct EpiSwiGLU {
    static constexpr bool PERM = true, AFTER_DRAIN = false;
    bf16_t* O; const float* ss;
    __device__ __forceinline__ void operator()(const f32x4 (&acc)[2][2][4][2], const Unit& u, int wr, int wc, int fr, int fq) const {
        const int row0 = u.pm * BM + wr * 64 + fr, col = u.pn * HALF + wc * 32 + 8 * fq;
        float rsv[2][4]; rows_rstd8(ss, row0, fq, rsv);
#pragma unroll
        for (int ai = 0; ai < 2; ++ai)
#pragma unroll
            for (int m = 0; m < 4; ++m) {
                const int row = row0 + ai * HALF + m * 16; const float rs = rsv[ai][m];
                float o[8];
#pragma unroll
                for (int n = 0; n < 2; ++n)
#pragma unroll
                    for (int k = 0; k < 4; ++k) { const float a = acc[ai][0][m][n][k] * rs, b = acc[ai][1][m][n][k] * rs; o[n * 4 + k] = a * b * __builtin_amdgcn_rcpf(1.0f + __builtin_amdgcn_exp2f(-1.4426950408889634f * a)); }
                u32x4 w; w.x = cvt_pk_bf16(o[0], o[1]); w.y = cvt_pk_bf16(o[2], o[3]); w.z = cvt_pk_bf16(o[4], o[5]); w.w = cvt_pk_bf16(o[6], o[7]);
                *(u32x4*)(O + (size_t)row * 2816 + col) = w;
            }
    }
};
template <class Epi, class Sched, bool ALIGN_EPI = false, bool SP2 = false>
__device__ __forceinline__ void gemm_phase(PG8_LAS unsigned char* lds, const Gemm g, const Sched& S, const Epi& E) {
    int tid_ = threadIdx.x; asm volatile("" : "+v"(tid_)); const int tid = tid_, wid = __builtin_amdgcn_readfirstlane(tid >> 6), lane = tid & 63, wr = wid >> 2, wc = wid & 3, fr = lane & 15, fq = lane >> 4;
    const int K = g.K, nt = K / BK;
    unsigned voffA[2], voffB[2];
#pragma unroll
    for (int i = 0; i < 2; ++i) { int R, C; stage_rc(tid * 16 + i * 8192, R, C); const int Rb = Epi::PERM ? ((R & ~31) + perm32(R & 31)) : R;
        voffA[i] = (unsigned)(R * K + C) * 2u; voffB[i] = (unsigned)(Rb * K + C) * 2u; }
    const size_t kstep = (size_t)(BK * 2);
    const size_t hstep = (size_t)HALF * K * 2;
    const size_t tstep = 2 * hstep;
    const unsigned ldsw = (unsigned)wid * 1024u;
    const int aoff = lds_byte(wr * 64 + fr, fq * 8), boff = lds_byte(wc * 32 + fr, fq * 8);
#define PG8_SA(b, h) (((b) * 2 + (h)) * HTB)
#define PG8_SB(b, h) ((4 + (b) * 2 + (h)) * HTB)
#define PG8_STAGE(bufoff, gbase, voff) do { _Pragma("unroll") for (int _i = 0; _i < 2; ++_i) \
        __builtin_amdgcn_global_load_lds((const unsigned*)((const char*)(gbase) + (voff)[_i]), (PG8_LAS unsigned*)(lds + (bufoff) + ldsw + _i * 8192), 16, 0, 0); } while (0)
#define PG8_LDA(dst, b, h) do { _Pragma("unroll") for (int m = 0; m < 4; ++m) _Pragma("unroll") for (int k = 0; k < 2; ++k) dst[m][k] = *(const PG8_LAS bf16x8*)(lds + PG8_SA(b, h) + aoff + m * 2048 + k * 1024); } while (0)
#define PG8_LDB(dst, b, h) do { _Pragma("unroll") for (int n = 0; n < 2; ++n) _Pragma("unroll") for (int k = 0; k < 2; ++k) dst[n][k] = *(const PG8_LAS bf16x8*)(lds + PG8_SB(b, h) + boff + n * 2048 + k * 1024); } while (0)
#define PG8_MMA(ai, bj, At, Bt) do { __builtin_amdgcn_s_setprio(1); _Pragma("unroll") for (int m = 0; m < 4; ++m) _Pragma("unroll") for (int n = 0; n < 2; ++n) _Pragma("unroll") for (int k = 0; k < 2; ++k) \
        acc[ai][bj][m][n] = __builtin_amdgcn_mfma_f32_16x16x32_bf16(Bt[n][k], At[m][k], acc[ai][bj][m][n], 0, 0, 0); __builtin_amdgcn_s_setprio(0); } while (0)
#define PG8_WAIT_V(n) asm volatile("s_waitcnt vmcnt(" #n ")" ::: "memory")
#define PG8_WAIT_L(n) asm volatile("s_waitcnt lgkmcnt(" #n ")" ::: "memory")
#define PG8_BAR __builtin_amdgcn_s_barrier()
#define PG8_SCHED __builtin_amdgcn_sched_barrier(0)
    Unit cur, nxt; int ui = 0;
    if (!S.next(0, cur)) return;
    f32x4 acc[2][2][4][2];
#pragma unroll
    for (int a = 0; a < 2; ++a)
#pragma unroll
        for (int b = 0; b < 2; ++b)
#pragma unroll
            for (int m = 0; m < 4; ++m)
#pragma unroll
                for (int n = 0; n < 2; ++n) acc[a][b][m][n] = (f32x4){0.f, 0.f, 0.f, 0.f};
    bf16x8 At[4][2], B0[2][2], B1[2][2];
    const char* cA = (const char*)g.A + (size_t)cur.pm * tstep; const char* cB = (const char*)g.Bt + (size_t)cur.pn * tstep;
    S.a_ready(cur);
    if constexpr (SP2) {
        PG8_STAGE(PG8_SB(0, 0), cB, voffB); PG8_STAGE(PG8_SB(0, 1), cB + hstep, voffB); PG8_STAGE(PG8_SA(0, 0), cA, voffA); PG8_STAGE(PG8_SA(0, 1), cA + hstep, voffA);
        if (wr == 1) PG8_BAR;
        PG8_WAIT_V(2); PG8_BAR;
        PG8_STAGE(PG8_SB(1, 0), cB + kstep, voffB); PG8_STAGE(PG8_SA(1, 0), cA + kstep, voffA); PG8_STAGE(PG8_SB(1, 1), cB + hstep + kstep, voffB);
        PG8_WAIT_V(6); PG8_BAR;
    } else {
        PG8_STAGE(PG8_SB(0, 0), cB, voffB); PG8_STAGE(PG8_SA(0, 0), cA, voffA); PG8_STAGE(PG8_SB(0, 1), cB + hstep, voffB); PG8_STAGE(PG8_SA(0, 1), cA + hstep, voffA);
        if (wr == 1) PG8_BAR;
        PG8_WAIT_V(4); PG8_BAR;
        PG8_STAGE(PG8_SB(1, 0), cB + kstep, voffB); PG8_STAGE(PG8_SA(1, 0), cA + kstep, voffA); PG8_STAGE(PG8_SB(1, 1), cB + hstep + kstep, voffB);
        PG8_WAIT_V(6); PG8_BAR;
    }
    for (;;) {
        const bool has_next = S.next(ui + 1, nxt);
        const char* nA = has_next ? (const char*)g.A + (size_t)nxt.pm * tstep : cA; const char* nB = has_next ? (const char*)g.Bt + (size_t)nxt.pn * tstep : cB;
        for (int t = 0; t < nt; t += 2) {
            const bool last = (t == nt - 2);
            const char* a1 = cA + (size_t)(t + 1) * kstep;
            const char* a2 = last ? nA : cA + (size_t)(t + 2) * kstep; const char* b2 = last ? nB : cB + (size_t)(t + 2) * kstep;
            const char* a3 = a2 + kstep; const char* b3 = b2 + kstep;
            if (last && has_next) S.a_ready(nxt);
            if constexpr (SP2) {
            PG8_LDB(B0, 0, 0); PG8_LDB(B1, 0, 1); PG8_SCHED; PG8_LDA(At, 0, 0); PG8_STAGE(PG8_SA(1, 1), a1 + hstep, voffA);
            PG8_WAIT_V(8); PG8_WAIT_L(0); PG8_BAR; PG8_MMA(0, 0, At, B0); PG8_MMA(0, 1, At, B1); PG8_BAR; PG8_SCHED;
            PG8_LDA(At, 0, 1); PG8_STAGE(PG8_SB(0, 0), b2, voffB); PG8_STAGE(PG8_SB(0, 1), b2 + hstep, voffB); PG8_STAGE(PG8_SA(0, 0), a2, voffA);
            PG8_WAIT_V(8); PG8_WAIT_L(0); PG8_BAR; PG8_MMA(1, 0, At, B0); PG8_MMA(1, 1, At, B1); PG8_BAR; PG8_SCHED;
            PG8_LDB(B0, 1, 0); PG8_LDB(B1, 1, 1); PG8_SCHED; PG8_LDA(At, 1, 0); PG8_STAGE(PG8_SA(0, 1), a2 + hstep, voffA);
            PG8_WAIT_V(8); PG8_WAIT_L(0); PG8_BAR; PG8_MMA(0, 0, At, B0); PG8_MMA(0, 1, At, B1); PG8_BAR; PG8_SCHED;
            PG8_LDA(At, 1, 1); PG8_STAGE(PG8_SB(1, 0), b3, voffB); PG8_STAGE(PG8_SB(1, 1), b3 + hstep, voffB); PG8_STAGE(PG8_SA(1, 0), a3, voffA);
            PG8_WAIT_V(8); PG8_WAIT_L(0); PG8_BAR; PG8_MMA(1, 0, At, B0); PG8_MMA(1, 1, At, B1); PG8_BAR; PG8_SCHED;
            } else {
            PG8_LDB(B0, 0, 0); PG8_SCHED; PG8_LDA(At, 0, 0); PG8_STAGE(PG8_SA(1, 1), a1 + hstep, voffA);
            PG8_WAIT_L(8); PG8_BAR; PG8_WAIT_L(0); PG8_MMA(0, 0, At, B0); PG8_BAR; PG8_SCHED;
            PG8_LDB(B1, 0, 1); PG8_STAGE(PG8_SB(0, 0), b2, voffB);
            PG8_BAR; PG8_WAIT_L(0); PG8_MMA(0, 1, At, B1); PG8_BAR;
            PG8_LDA(At, 0, 1); PG8_STAGE(PG8_SA(0, 0), a2, voffA);
            PG8_BAR; PG8_WAIT_L(0); PG8_MMA(1, 0, At, B0); PG8_BAR; PG8_SCHED;
            PG8_STAGE(PG8_SB(0, 1), b2 + hstep, voffB);
            PG8_WAIT_V(6); PG8_BAR; PG8_MMA(1, 1, At, B1); PG8_BAR;
            PG8_LDB(B0, 1, 0); PG8_SCHED; PG8_LDA(At, 1, 0); PG8_STAGE(PG8_SA(0, 1), a2 + hstep, voffA);
            PG8_WAIT_L(8); PG8_BAR; PG8_WAIT_L(0); PG8_MMA(0, 0, At, B0); PG8_BAR; PG8_SCHED;
            PG8_LDB(B1, 1, 1); PG8_STAGE(PG8_SB(1, 0), b3, voffB);
            PG8_BAR; PG8_WAIT_L(0); PG8_MMA(0, 1, At, B1); PG8_BAR;
            PG8_LDA(At, 1, 1); PG8_STAGE(PG8_SA(1, 0), a3, voffA);
            PG8_BAR; PG8_WAIT_L(0); PG8_MMA(1, 0, At, B0); PG8_BAR; PG8_SCHED;
            PG8_STAGE(PG8_SB(1, 1), b3 + hstep, voffB);
            PG8_WAIT_V(6); PG8_BAR; PG8_MMA(1, 1, At, B1); PG8_BAR;
            }
        }
        if constexpr (ALIGN_EPI) { if (wr == 0) PG8_BAR; }
        if constexpr (!Epi::AFTER_DRAIN) { E(acc, cur, wr, wc, fr, fq); S.done(cur); }
        if (!has_next) break;
#pragma unroll
        for (int a = 0; a < 2; ++a)
#pragma unroll
            for (int b = 0; b < 2; ++b)
#pragma unroll
                for (int m = 0; m < 4; ++m)
#pragma unroll
                    for (int n = 0; n < 2; ++n) acc[a][b][m][n] = (f32x4){0.f, 0.f, 0.f, 0.f};
        cur = nxt; cA = nA; cB = nB; ++ui;
        if constexpr (ALIGN_EPI) { if (wr == 1) PG8_BAR; }
    }
    PG8_WAIT_V(0);
    if constexpr (!ALIGN_EPI) { if (wr == 0) PG8_BAR; }
    PG8_BAR;
    if constexpr (Epi::AFTER_DRAIN) { E.fused(acc, cur, wr, wc, fr, fq, lds, wid, lane); S.done(cur); }
#undef PG8_SA
#undef PG8_SB
#undef PG8_STAGE
#undef PG8_LDA
#undef PG8_LDB
#undef PG8_MMA
#undef PG8_WAIT_V
#undef PG8_WAIT_L
#undef PG8_BAR
#undef PG8_SCHED
}
}
#define LAS __attribute__((address_space(3)))
typedef unsigned short bf16;
typedef short bf16x8 __attribute__((ext_vector_type(8)));
typedef short s16x4 __attribute__((ext_vector_type(4)));
typedef float f32x4 __attribute__((ext_vector_type(4)));
typedef float f32x16 __attribute__((ext_vector_type(16)));
typedef unsigned u32x4 __attribute__((ext_vector_type(4)));
typedef unsigned u32x2 __attribute__((ext_vector_type(2)));
constexpr int NB = 16, SEQ = 2048, DM = 1024, MTOK = NB * SEQ, NH = 16, HD = 64, NG = 4;
constexpr int NSA_W = 2608, NSA_P = 2816, SB_P = 3072, DFF = 2816, DFF2 = 5632;
constexpr float LOG2E = 1.4426950408889634f, LN2 = 0.6931471805599453f;
constexpr size_t MiB = 1u << 20;
constexpr size_t WS_WNSA = 0, WS_WSB = 12 * MiB, WS_WOUT = 24 * MiB, WS_W13 = 32 * MiB, WS_W2 = 76 * MiB, WS_CW1 = 98 * MiB, WS_CW2 = 102 * MiB,
                 WS_CBIAS = 102 * MiB + 256 * 1024, WS_KC = 103 * MiB, WS_VCT = 104 * MiB, WS_SS = 105 * MiB, WS_GATES = 107 * MiB, WS_HB = 114 * MiB,
                 WS_O = 178 * MiB, WS_PROJ = 242 * MiB, WS_CTL = 436 * MiB, WS_END = 437 * MiB;
constexpr int LDS_BYTES = 147456 + 1024;
#ifndef TSEL
#define TSEL -1
#endif

struct Params { const float* in[15]; float* out; unsigned char* ws; int ph_lo, ph_hi; };

__device__ __forceinline__ unsigned f2bf(float f) { unsigned u = __builtin_bit_cast(unsigned, f); return (u + 0x7fffu + ((u >> 16) & 1u)) >> 16; }
__device__ __forceinline__ unsigned pk2(float lo, float hi) { return pg8::cvt_pk_bf16(lo, hi); }
__device__ __forceinline__ float wave_sum(float v) {
#pragma unroll
    for (int o = 1; o < 64; o <<= 1) v += __shfl_xor(v, o);
    return v;
}
__device__ __forceinline__ float swap32(float v) {
    const unsigned u = __builtin_bit_cast(unsigned, v);
    auto rr = __builtin_amdgcn_permlane32_swap(u, u, false, false);
    return __builtin_bit_cast(float, (threadIdx.x & 32) ? (unsigned)rr[0] : (unsigned)rr[1]);
}
__device__ __forceinline__ int crow(int r, int hi) { return (r & 3) + 8 * (r >> 2) + 4 * hi; }
__device__ __forceinline__ bf16x8 pack8(float a0, float a1, float a2, float a3, float a4, float a5, float a6, float a7) {
    u32x4 w; w.x = pk2(a0, a1); w.y = pk2(a2, a3); w.z = pk2(a4, a5); w.w = pk2(a6, a7); return __builtin_bit_cast(bf16x8, w);
}
typedef short v4i16_t __attribute__((ext_vector_type(4)));
__device__ __forceinline__ s16x4 vtr(const LAS unsigned char* p) { return __builtin_bit_cast(s16x4, __builtin_amdgcn_ds_read_tr16_b64_v4i16((LAS v4i16_t*)p)); }
#define MFMA32(a, b, c) __builtin_amdgcn_mfma_f32_32x32x16_bf16((a), (b), (c), 0, 0, 0)
#define MFMA16(a, b, c) __builtin_amdgcn_mfma_f32_16x16x32_bf16((a), (b), (c), 0, 0, 0)
#define LDS_FENCE() asm volatile("s_waitcnt lgkmcnt(0)" ::: "memory")

struct TrDesc { const float* W; int K, N; bf16* WT; int ldt; const float* ks; float qscale; int qcols; int mode; };
__device__ __forceinline__ void transpose_item(const TrDesc& d, LAS float* scr, int item, int lane) {
    const int nblk = (d.N + 31) >> 5, kb = item / nblk, nb = item - kb * nblk, k0 = 64 * kb, n0 = 32 * nb;
    const int nn = n0 + (lane & 31);
    float tv[32];
#pragma unroll
    for (int i = 0; i < 32; ++i) { const int kk = 2 * i + (lane >> 5); tv[i] = (nn < d.N) ? d.W[(size_t)(k0 + kk) * d.N + nn] : 0.f; }
    if (d.ks) {
#pragma unroll
        for (int i = 0; i < 32; ++i) tv[i] *= d.ks[k0 + 2 * i + (lane >> 5)];
    }
#pragma unroll
    for (int i = 0; i < 32; ++i) scr[(2 * i + (lane >> 5)) * 33 + (lane & 31)] = tv[i];
    LDS_FENCE();
    const int c = lane & 7;
#pragma unroll
    for (int j = 0; j < 4; ++j) {
        const int nl = (lane >> 3) + 8 * j, n = n0 + nl; const LAS float* s = scr + (8 * c) * 33 + nl;
        const float sc = (n < d.qcols) ? d.qscale : 1.0f;
        u32x4 o; o.x = pk2(s[0 * 33] * sc, s[1 * 33] * sc); o.y = pk2(s[2 * 33] * sc, s[3 * 33] * sc); o.z = pk2(s[4 * 33] * sc, s[5 * 33] * sc); o.w = pk2(s[6 * 33] * sc, s[7 * 33] * sc);
        const int row = d.mode == 0 ? n : (256 * (n >> 7) + (n & 127) + (d.mode == 2 ? 128 : 0));
        const size_t dst = (d.mode == 3) ? ((size_t)((k0 >> 6) * d.N + n) * 64 + 8 * c) : ((size_t)row * d.ldt + k0 + 8 * c);
        if (n < d.N) *(u32x4*)(d.WT + dst) = o;
    }
    LDS_FENCE();
}

__device__ __forceinline__ void prologue(const Params& p, LAS unsigned char* lds, int G) {
    int tid_ = threadIdx.x; asm volatile("" : "+v"(tid_)); const int tid = tid_, lane = tid & 63, wave = __builtin_amdgcn_readfirstlane(tid >> 6);
    LAS float* scr = (LAS float*)(lds + wave * 16384);
    const int gw = blockIdx.x * 8 + wave, NGW = G * 8;
    unsigned char* ws = p.ws;
    const float* mixg = p.in[1]; const float* ffng = p.in[2];
    { constexpr int IT = 16 * 82;
      for (int it = gw; it < 2 * IT; it += NGW) { const int j = it / IT, r = it - j * IT;
        TrDesc d{p.in[4] + (size_t)j * DM * NSA_W, DM, NSA_W, (bf16*)(ws + WS_WNSA) + (size_t)j * NSA_P * DM, DM, mixg + (2 * j) * DM, 0.125f * LOG2E, 1024, 0};
        transpose_item(d, scr, r, lane); } }
    { constexpr int IT = 16 * 96;
      for (int it = gw; it < 2 * IT; it += NGW) { const int j = it / IT, r = it - j * IT;
        TrDesc d{p.in[10] + (size_t)j * DM * SB_P, DM, SB_P, (bf16*)(ws + WS_WSB) + (size_t)j * SB_P * DM, DM, mixg + (2 * j + 1) * DM, 0.125f * LOG2E, 1024, 0};
        transpose_item(d, scr, r, lane); } }
    { constexpr int IT = 16 * 32;
      for (int it = gw; it < 4 * IT; it += NGW) { const int i = it / IT, r = it - i * IT;
        const float* W = ((i & 1) ? p.in[11] : p.in[9]) + (size_t)(i >> 1) * DM * DM;
        TrDesc d{W, DM, DM, (bf16*)(ws + WS_WOUT) + (size_t)i * DM * DM, DM, nullptr, 1.f, 0, 0};
        transpose_item(d, scr, r, lane); } }
    { constexpr int IT = 16 * 88;
      for (int it = gw; it < 8 * IT; it += NGW) { const int q = it / IT, r = it - q * IT, i = q & 3, which = q >> 2;
        TrDesc d{(which ? p.in[13] : p.in[12]) + (size_t)i * DM * DFF, DM, DFF, (bf16*)(ws + WS_W13) + (size_t)i * DFF2 * DM, DM, ffng + i * DM, 1.f, 0, which ? 2 : 1};
        transpose_item(d, scr, r, lane); } }
    { constexpr int IT = 44 * 32;
      for (int it = gw; it < 4 * IT; it += NGW) { const int i = it / IT, r = it - i * IT;
        TrDesc d{p.in[14] + (size_t)i * DFF * DM, DFF, DM, (bf16*)(ws + WS_W2) + (size_t)i * DM * DFF, DFF, nullptr, 1.f, 0, 0};
        transpose_item(d, scr, r, lane); } }
    { constexpr int IT = 32 * 8;
      for (int it = gw; it < 4 * IT; it += NGW) { const int q = it / IT, r = it - q * IT;
        TrDesc d{p.in[7] + (size_t)q * 2048 * 256, 2048, 256, (bf16*)(ws + WS_CW1) + (size_t)q * 256 * 2048, 2048, nullptr, 1.f, 0, 3};
        transpose_item(d, scr, r, lane); } }
    { constexpr int IT = 4 * 2;
      for (int it = gw; it < 4 * IT; it += NGW) { const int q = it / IT, r = it - q * IT;
        TrDesc d{p.in[8] + (size_t)q * 256 * 64, 256, 64, (bf16*)(ws + WS_CW2) + (size_t)q * 64 * 256, 256, nullptr, 1.f, 0, 0};
        transpose_item(d, scr, r, lane); } }
    { const float* x = p.in[0]; bf16* hb = (bf16*)(ws + WS_HB); float* ss = (float*)(ws + WS_SS);
      for (int m0 = gw * 4; m0 < MTOK; m0 += NGW * 4) {
        f32x4 v[4][4]; float sm[4];
#pragma unroll
        for (int q = 0; q < 4; ++q) { const f32x4* xr = (const f32x4*)(x + (size_t)(m0 + q) * DM) + lane;
#pragma unroll
          for (int j = 0; j < 4; ++j) v[q][j] = xr[64 * j]; }
#pragma unroll
        for (int q = 0; q < 4; ++q) { float t = 0.f;
#pragma unroll
          for (int j = 0; j < 4; ++j) t += (v[q][j][0] * v[q][j][0] + v[q][j][1] * v[q][j][1]) + (v[q][j][2] * v[q][j][2] + v[q][j][3] * v[q][j][3]);
          sm[q] = wave_sum(t); }
#pragma unroll
        for (int q = 0; q < 4; ++q) { u32x2* o8 = (u32x2*)(hb + (size_t)(m0 + q) * DM) + lane;
#pragma unroll
          for (int j = 0; j < 4; ++j) { u32x2 w; w.x = pk2(v[q][j][0], v[q][j][1]); w.y = pk2(v[q][j][2], v[q][j][3]); o8[64 * j] = w; } }
        { const int q = lane >> 4, c = lane & 15; const float tot = q == 0 ? sm[0] : q == 1 ? sm[1] : q == 2 ? sm[2] : sm[3]; ss[(size_t)(m0 + q) * 16 + c] = (c == 0) ? tot : 0.f; }
      } }
    { float* part = (float*)(ws + WS_CBIAS);
      for (int t = gw; t < 4 * 32; t += NGW) { const int q = t >> 5, kc = t & 31;
        const float* pe = p.in[6] + (size_t)q * 2048 + kc * 64; const float* W = p.in[7] + (size_t)q * 2048 * 256 + (size_t)kc * 64 * 256;
        f32x4 a = {0.f, 0.f, 0.f, 0.f};
#pragma unroll 16
        for (int k = 0; k < 64; ++k) { const float e = pe[k]; const f32x4 w = *((const f32x4*)(W + (size_t)k * 256) + lane); a += w * e; }
        *((f32x4*)(part + (size_t)(q * 32 + kc) * 256) + lane) = a; } }
    { const int gt = blockIdx.x * 512 + tid, NT = G * 512; constexpr int PER = (NSA_P - NSA_W) * DM * 2 / 16;
      for (int i = gt; i < 2 * PER; i += NT) { const int j = i / PER, r = i - j * PER;
        *((u32x4*)((bf16*)(ws + WS_WNSA) + (size_t)j * NSA_P * DM + (size_t)NSA_W * DM) + r) = (u32x4){0u, 0u, 0u, 0u}; } }
}

__device__ __forceinline__ float gelu_tanh(float v) {
    const float u = 0.7978845608028654f * (v + 0.044715f * v * v * v);
    const float t = 1.0f - 2.0f / (1.0f + __expf(2.0f * u));
    return 0.5f * v * (1.0f + t);
}
__device__ __forceinline__ void compress_phase(const Params& p, LAS unsigned char* lds, int G, int layerj) {
    int tid_ = threadIdx.x; asm volatile("" : "+v"(tid_)); const int tid = tid_, lane = tid & 63, w = __builtin_amdgcn_readfirstlane(tid >> 6), l15 = lane & 15, l4 = lane >> 4;
    unsigned char* ws = p.ws;
    const bf16* proj = (const bf16*)(ws + WS_PROJ);
    LAS bf16* hid = (LAS bf16*)lds;
    for (int unit = blockIdx.x; unit < 256; unit += G) {
        const int kv = unit & 1, half = (unit >> 1) & 1, bg = unit >> 2, b = bg >> 2, g = bg & 3, n0 = half * 64;
        const int q = layerj * 2 + kv;
        const bf16* w1t = (const bf16*)(ws + WS_CW1) + (size_t)q * 256 * 2048;
        const bf16* w2t = (const bf16*)(ws + WS_CW2) + (size_t)q * 64 * 256;
        const float* part = (const float*)(ws + WS_CBIAS) + (size_t)q * 32 * 256;
        const int colbase = (kv ? 1280 : 1024) + g * 64;
        LAS unsigned char* abuf = lds + 36864;
        const bf16* asrc = proj + (size_t)(b * SEQ + 16 * (n0 + (tid >> 3))) * NSA_P + colbase + (tid & 7) * 8;
        const int awr = (tid >> 3) * 144 + (tid & 7) * 16;
        const LAS unsigned char* ard = abuf + l15 * 144 + l4 * 16;
        const bf16* bsrc = w1t + (size_t)(32 * w + l15) * 64 + l4 * 8;
        LAS float* biasl = (LAS float*)(lds + 64 * 264 * 2);
        if (tid < 256) { float pv[32];
#pragma unroll
            for (int kc = 0; kc < 32; ++kc) pv[kc] = part[kc * 256 + tid];
            float bsum = 0.f;
#pragma unroll
            for (int kc = 0; kc < 32; ++kc) bsum += pv[kc];
            biasl[tid] = bsum; }
        f32x4 acc[4][2];
#pragma unroll
        for (int rb = 0; rb < 4; ++rb)
#pragma unroll
            for (int cb = 0; cb < 2; ++cb) acc[rb][cb] = (f32x4){0.f, 0.f, 0.f, 0.f};
        u32x4 ga; bf16x8 fb[2][2][2];
#define CMP_LOADB(buf, l) do { _Pragma("unroll") for (int ks = 0; ks < 2; ++ks) _Pragma("unroll") for (int cb = 0; cb < 2; ++cb) \
            fb[buf][ks][cb] = *(const bf16x8*)(bsrc + (size_t)(l) * 256 * 64 + cb * 16 * 64 + ks * 32); } while (0)
#define CMP_STEP(buf, l) do { \
            bf16x8 fa[2][4]; \
            _Pragma("unroll") for (int ks = 0; ks < 2; ++ks) _Pragma("unroll") for (int rb = 0; rb < 4; ++rb) fa[ks][rb] = *(const LAS bf16x8*)(ard + (buf) * 9216 + rb * 16 * 144 + ks * 64); \
            _Pragma("unroll") for (int ks = 0; ks < 2; ++ks) _Pragma("unroll") for (int rb = 0; rb < 4; ++rb) _Pragma("unroll") for (int cb = 0; cb < 2; ++cb) \
                acc[rb][cb] = MFMA16(fa[ks][rb], fb[buf][ks][cb], acc[rb][cb]); \
            if ((l) + 1 < 32) *(LAS u32x4*)(abuf + ((buf) ^ 1) * 9216 + awr) = ga; \
            if ((l) + 2 < 32) { ga = *(const u32x4*)(asrc + (size_t)((l) + 2) * NSA_P); CMP_LOADB(buf, (l) + 2); } \
            __syncthreads(); } while (0)
        ga = *(const u32x4*)asrc; CMP_LOADB(0, 0);
        *(LAS u32x4*)(abuf + awr) = ga;
        ga = *(const u32x4*)(asrc + NSA_P); CMP_LOADB(1, 1);
        __syncthreads();
#pragma unroll 1
        for (int l = 0; l < 32; l += 2) { CMP_STEP(0, l); CMP_STEP(1, l + 1); }
#undef CMP_LOADB
#undef CMP_STEP
        __syncthreads();
#pragma unroll
        for (int cb = 0; cb < 2; ++cb) {
            const int col = 32 * w + 16 * cb + l15; const float bias = biasl[col];
#pragma unroll
            for (int rb = 0; rb < 4; ++rb)
#pragma unroll
                for (int j = 0; j < 4; ++j) hid[(16 * rb + l4 * 4 + j) * 264 + col] = (bf16)f2bf(gelu_tanh(acc[rb][cb][j] + bias));
        }
        __syncthreads();
        const int rb2 = w >> 1;
        f32x4 o2[2] = {(f32x4){0.f, 0.f, 0.f, 0.f}, (f32x4){0.f, 0.f, 0.f, 0.f}};
#pragma unroll
        for (int ks = 0; ks < 8; ++ks) {
            const bf16x8 a = *(const LAS bf16x8*)(hid + (16 * rb2 + l15) * 264 + ks * 32 + l4 * 8);
#pragma unroll
            for (int c2 = 0; c2 < 2; ++c2) {
                const int cb = 2 * (w & 1) + c2;
                const bf16x8 bb = *(const bf16x8*)(w2t + (size_t)(16 * cb + l15) * 256 + ks * 32 + l4 * 8);
                o2[c2] = MFMA16(a, bb, o2[c2]);
            }
        }
#pragma unroll
        for (int c2 = 0; c2 < 2; ++c2) {
            const int d = 16 * (2 * (w & 1) + c2) + l15, nb = n0 + 16 * rb2 + l4 * 4;
            float v[4];
#pragma unroll
            for (int j = 0; j < 4; ++j) v[j] = (nb + j == 127) ? 0.f : o2[c2][j];
            if (kv == 0) {
                bf16* kc = (bf16*)(ws + WS_KC) + (size_t)((b * 4 + g) * 128) * 64;
#pragma unroll
                for (int j = 0; j < 4; ++j) kc[(size_t)(nb + j) * 64 + d] = (bf16)f2bf(v[j]);
            } else {
                bf16* vct = (bf16*)(ws + WS_VCT) + (size_t)((b * 4 + g) * 64 + d) * 128 + nb;
                u32x2 wv; wv.x = pk2(v[0], v[1]); wv.y = pk2(v[2], v[3]); *(u32x2*)vct = wv;
            }
        }
        __syncthreads();
    }
}
#if TSEL >= 9
#define SECT_INIT() unsigned long long t_sect = __builtin_amdgcn_s_memrealtime()
#define SECT(k) do { if (blockIdx.x == 0 && tid == 0) { const unsigned long long t_now = __builtin_amdgcn_s_memrealtime(); ((LAS unsigned long long*)(lds + 147456 + 800))[k] += t_now - t_sect; t_sect = t_now; } } while (0)
#else
#define SECT_INIT() do {} while (0)
#define SECT(k) do {} while (0)
#endif
struct AttnState { float m, l; f32x16 o0, o1; };
constexpr int KV_BUF = 16384;
template <bool ELEM_MASK>
__device__ __forceinline__ void attn_tile(AttnState& st, const LAS unsigned char* qrl, const LAS unsigned char* kb, const LAS unsigned char* vb,
                                          float base, float slope2, int key0, int tq, int lo_q, int r32, int hi, int lane, bool first) {
    const LAS unsigned char* vp = vb + (4 * hi + ((lane & 15) >> 2)) * 64 + ((lane >> 4) & 1) * 32 + (lane & 3) * 8;
    const int rel = tq - key0 - 4 * hi, rello = lo_q - key0 - 4 * hi;
    f32x16 p0, p1;
    const float hbm = (base + slope2 * (float)(4 * hi)) - st.m;
#pragma unroll
    for (int r = 0; r < 16; ++r) { const int cr = (r & 3) + 8 * (r >> 2); p0[r] = hbm + slope2 * (float)cr; p1[r] = hbm + slope2 * (float)(cr + 32); }
#pragma unroll
    for (int d0 = 0; d0 < 4; ++d0) {
        const bf16x8 k0 = *(const LAS bf16x8*)(kb + (2 * d0 + hi) * 1024 + r32 * 16);
        const bf16x8 k1 = *(const LAS bf16x8*)(kb + (2 * d0 + hi) * 1024 + 512 + r32 * 16);
        const bf16x8 qf = *(const LAS bf16x8*)(qrl + d0 * 1024);
        p0 = MFMA32(k0, qf, p0); p1 = MFMA32(k1, qf, p1);
    }
    float mx = -INFINITY;
#pragma unroll
    for (int r = 0; r < 16; ++r) {
        if (ELEM_MASK) { const int cr = (r & 3) + 8 * (r >> 2); p0[r] = (cr <= rel && cr >= rello) ? p0[r] : -INFINITY; p1[r] = (cr + 32 <= rel && cr + 32 >= rello) ? p1[r] : -INFINITY; }
        mx = fmaxf(mx, fmaxf(p0[r], p1[r]));
    }
    mx = fmaxf(mx, swap32(mx));
    if (!first && __all(mx < -34.f)) return;
    if (first || __any(mx > 0.f)) {
        const float delta = first ? (mx > -1e30f ? mx : 0.f) : fmaxf(mx, 0.f);
        const float alpha = __builtin_amdgcn_exp2f(-delta);
        st.m += delta; st.l *= alpha;
#pragma unroll
        for (int r = 0; r < 16; ++r) { st.o0[r] *= alpha; st.o1[r] *= alpha; p0[r] -= delta; p1[r] -= delta; }
    }
    float rs = 0.f;
#pragma unroll
    for (int r = 0; r < 16; ++r) { p0[r] = __builtin_amdgcn_exp2f(p0[r]); p1[r] = __builtin_amdgcn_exp2f(p1[r]); rs += p0[r] + p1[r]; }
    st.l += rs;
    bf16x8 pb[4];
    pb[0] = pack8(p0[0], p0[1], p0[2], p0[3], p0[4], p0[5], p0[6], p0[7]);
    pb[1] = pack8(p0[8], p0[9], p0[10], p0[11], p0[12], p0[13], p0[14], p0[15]);
    pb[2] = pack8(p1[0], p1[1], p1[2], p1[3], p1[4], p1[5], p1[6], p1[7]);
    pb[3] = pack8(p1[8], p1[9], p1[10], p1[11], p1[12], p1[13], p1[14], p1[15]);
#pragma unroll
    for (int ks = 0; ks < 4; ++ks) {
        const s16x4 a0 = vtr(vp + ks * 1024), a1 = vtr(vp + ks * 1024 + 512), c0 = vtr(vp + 4096 + ks * 1024), c1 = vtr(vp + 4096 + ks * 1024 + 512);
        const bf16x8 v0 = __builtin_shufflevector(a0, a1, 0, 1, 2, 3, 4, 5, 6, 7);
        const bf16x8 v1 = __builtin_shufflevector(c0, c1, 0, 1, 2, 3, 4, 5, 6, 7);
        st.o0 = MFMA32(v0, pb[ks], st.o0); st.o1 = MFMA32(v1, pb[ks], st.o1);
    }
}

constexpr int CMPV_PITCH = 264, IMP_OFF = 34816, SELM_OFF = IMP_OFF + 4 * 64 * 33 * 4, OACC_OFF = SELM_OFF + 256;
__device__ __forceinline__ void nsa_tiles(AttnState& st, LAS unsigned char* lds, unsigned tilesS, unsigned tilesW, const bf16* kvbase  ,
                                          unsigned mysel, float slope2, int tq, int qt, int lane, int w, u32x4 kA, u32x4 vA, float gate_s  ) {
    asm volatile("" : "+v"(lane));
    const int r32 = lane & 31, hi = lane >> 5;
    const LAS unsigned char* qrl = lds + IMP_OFF + w * 4096 + lane * 16;
    const bf16* ksrc = kvbase + (size_t)lane * NSA_P + w * 8;
    const bf16* vsrc = kvbase + 256 + (size_t)(16 * (w & 3) + (lane >> 2)) * NSA_P + (w >> 2) * 32 + (lane & 3) * 8;
    const int sto = w * 1024 + lane * 16;
    unsigned remS = tilesS & ~(1u << qt), remW = tilesW;
#define NSA_POP(code) do { if (remS) { const int j_ = 31 - __builtin_clz(remS); remS &= ~(1u << j_); code = j_; } \
                          else if (remW) { const int j_ = 31 - __builtin_clz(remW); remW &= ~(1u << j_); code = 32 + j_; } else code = -1; } while (0)
#define NSA_FETCH(KR, VR, code) do { const int cc_ = (code) >= 0 ? (code) : qt;     \
        const size_t off_ = (size_t)(cc_ & 31) * 64 * NSA_P + (cc_ >> 5) * 512; KR = *(const u32x4*)(ksrc + off_); VR = *(const u32x4*)(vsrc + off_); } while (0)
    int c0 = qt, c1, c2; bool first = true;
    u32x4 kB, vB;
    NSA_POP(c1); NSA_FETCH(kB, vB, c1);
    *(LAS u32x4*)(lds + sto) = kA; *(LAS u32x4*)(lds + 8192 + sto) = vA;
    __syncthreads();
    int buf = 0;
#define NSA_STEP(KN, VN, KF, VF) do { \
        NSA_POP(c2); NSA_FETCH(KF, VF, c2); \
        { const int phase = c0 >> 5, j = c0 & 31; \
          const LAS unsigned char* kb = lds + buf * KV_BUF; const LAS unsigned char* vb = kb + 8192; \
          const bool selq = phase ? true : (((mysel >> j) & 1u) != 0u); \
          const float base = selq ? slope2 * (float)(64 * j - tq) : -INFINITY; \
          const int lo_q = phase ? tq - 511 : -(1 << 30); \
          if (j == qt || (phase && j == qt - 8)) attn_tile<true>(st, qrl, kb, vb, base, slope2, 64 * j, tq, lo_q, r32, hi, lane, first); \
          else attn_tile<false>(st, qrl, kb, vb, base, slope2, 64 * j, tq, lo_q, r32, hi, lane, false); } \
        { LAS unsigned char* nb = lds + (buf ^ 1) * KV_BUF; *(LAS u32x4*)(nb + sto) = KN; *(LAS u32x4*)(nb + 8192 + sto) = VN; }     \
        __syncthreads(); \
        first = false; \
        if (c1 >= 0 && (c1 >> 5) != (c0 >> 5)) {     \
            first = true; \
            LAS float* oacc2 = (LAS float*)(lds + OACC_OFF) + w * 2048 + lane; \
            const float lt = st.l + swap32(st.l); const float sc = gate_s / lt; \
            _Pragma("unroll") for (int r = 0; r < 16; ++r) { oacc2[r * 64] += st.o0[r] * sc; oacc2[(16 + r) * 64] += st.o1[r] * sc; } \
            st.m = 0.f; st.l = 0.f; \
            _Pragma("unroll") for (int r = 0; r < 16; ++r) { st.o0[r] = 0.f; st.o1[r] = 0.f; } } \
        c0 = c1; c1 = c2; buf ^= 1; } while (0)
    for (;;) {
        NSA_STEP(kB, vB, kA, vA);
        if (c0 < 0) break;
        NSA_STEP(kA, vA, kB, vB);
        if (c0 < 0) break;
    }
#undef NSA_POP
#undef NSA_FETCH
#undef NSA_STEP
}

__device__ __forceinline__ void nsa_attn_phase(const Params& p, LAS unsigned char* lds, int G) {
    int tid_ = threadIdx.x; asm volatile("" : "+v"(tid_)); const int tid = tid_, lane = tid & 63, w = __builtin_amdgcn_readfirstlane(tid >> 6), r32 = lane & 31, hi = lane >> 5, hh = w & 3, tb = w >> 2;
    unsigned char* ws = p.ws;
    const bf16* proj = (const bf16*)(ws + WS_PROJ);
    const float* gates = (const float*)(ws + WS_GATES);
    bf16* obuf = (bf16*)(ws + WS_O);
    LAS float* impw = (LAS float*)(lds + IMP_OFF);
    LAS unsigned* selm = (LAS unsigned*)(lds + SELM_OFF);
    for (int u = blockIdx.x; u < 2048; u += G) {
        SECT_INIT();
        int bg, qt;
        if (G == 256) { const int r = u >> 8, k = u & 255, c = k >> 6; bg = (k & 63) ^ (r & 3); qt = (r & 1) ? 4 * r + 3 - c : 4 * r + c; }
        else { bg = u & 63; qt = u >> 6; }
        const int b = bg >> 2, g = bg & 3, head = 4 * g + hh;
        const float slope2 = __builtin_amdgcn_exp2f(-0.5f * (float)(head + 1)) * LOG2E;
        const int tq = 64 * qt + 32 * tb + r32; const size_t row = (size_t)b * SEQ + tq;
        bf16x8 qr[4];
        { const bf16* qp = proj + row * NSA_P + head * 64 + hi * 8;
#pragma unroll
          for (int d0 = 0; d0 < 4; ++d0) qr[d0] = *(const bf16x8*)(qp + d0 * 16); }
        const float gate_c = gates[row * 48 + head], gate_s = gates[row * 48 + 16 + head], gate_w = gates[row * 48 + 32 + head];
        LAS float* oacc = (LAS float*)(lds + OACC_OFF) + w * 2048 + lane;
        const bf16* kvbase = proj + (size_t)b * SEQ * NSA_P + 1536 + g * 64;
        const u32x4 kreg0 = *(const u32x4*)(kvbase + (size_t)(64 * qt + lane) * NSA_P + w * 8);
        const u32x4 vreg0 = *(const u32x4*)(kvbase + 256 + (size_t)(64 * qt + 16 * (w & 3) + (lane >> 2)) * NSA_P + (w >> 2) * 32 + (lane & 3) * 8);
        {
            const int nct = (4 * qt + 3 + 31) >> 5;
            const bf16* kcb = (const bf16*)(ws + WS_KC) + (size_t)((b * 4 + g) * 128) * 64;
            const bf16* vctb = (const bf16*)(ws + WS_VCT) + (size_t)((b * 4 + g) * 64) * 128;
            {
                u32x4 kk[2], vv[2];
#pragma unroll
                for (int i = 0; i < 2; ++i) { const int id = tid + 512 * i; kk[i] = *(const u32x4*)(kcb + (size_t)(id >> 3) * 64 + (id & 7) * 8); vv[i] = *(const u32x4*)(vctb + (size_t)(id >> 4) * 128 + (id & 15) * 8); }
#pragma unroll
                for (int i = 0; i < 2; ++i) { const int id = tid + 512 * i;
                    *(LAS u32x4*)(lds + (id & 7) * 2048 + (id >> 3) * 16) = kk[i];
                    LAS unsigned char* vd = lds + 16384 + (id >> 4) * CMPV_PITCH + (id & 15) * 16;
                    *(LAS u32x2*)vd = (u32x2){vv[i].x, vv[i].y}; *(LAS u32x2*)(vd + 8) = (u32x2){vv[i].z, vv[i].w}; }
            }
            __syncthreads();
            const LAS unsigned char* kcl = lds + hi * 2048 + r32 * 16;
            const LAS unsigned char* vcl = lds + 16384 + r32 * CMPV_PITCH + 8 * hi;
            float m = -1e30f, l = 0.f;
#pragma unroll 1
            for (int t = 0; t < nct; ++t) {
                f32x16 a;
#pragma unroll
                for (int r = 0; r < 16; ++r) a[r] = 0.f;
#pragma unroll
                for (int d0 = 0; d0 < 4; ++d0) { const bf16x8 kf = *(const LAS bf16x8*)(kcl + d0 * 4096 + t * 512); a = MFMA32(kf, qr[d0], a); }
                float mx = -INFINITY;
#pragma unroll
                for (int r = 0; r < 16; ++r) { const int n = 32 * t + crow(r, hi), cend = 16 * n + 31; const float sv = a[r] + slope2 * (float)(cend - tq); a[r] = (cend <= tq) ? sv : -INFINITY; mx = fmaxf(mx, a[r]); }
                mx = fmaxf(mx, swap32(mx));
                const float mnew = fmaxf(m, mx); float rs = 0.f;
#pragma unroll
                for (int r = 0; r < 16; ++r) rs += __builtin_amdgcn_exp2f(a[r] - mnew);
                l = l * __builtin_amdgcn_exp2f(m - mnew) + rs; m = mnew;
            }
            l += swap32(l);
            const float inv = (l > 0.f) ? 1.0f / l : 0.f;
            LAS float* myimp = impw + (hh * 64 + tb * 32 + r32) * 33;
            float carry3 = 0.f;
            f32x16 out0, out1;
#pragma unroll
            for (int r = 0; r < 16; ++r) { out0[r] = 0.f; out1[r] = 0.f; }
#pragma unroll 1
            for (int t = 0; t < nct; ++t) {
                f32x16 a;
#pragma unroll
                for (int r = 0; r < 16; ++r) a[r] = 0.f;
#pragma unroll
                for (int d0 = 0; d0 < 4; ++d0) { const bf16x8 kf = *(const LAS bf16x8*)(kcl + d0 * 4096 + t * 512); a = MFMA32(kf, qr[d0], a); }
#pragma unroll
                for (int r = 0; r < 16; ++r) { const int n = 32 * t + crow(r, hi), cend = 16 * n + 31; const float sv = a[r] + slope2 * (float)(cend - tq); a[r] = (cend <= tq) ? __builtin_amdgcn_exp2f(sv - m) * inv : 0.f; }
                float rcv[4];
#pragma unroll
                for (int i = 0; i < 4; ++i) rcv[i] = swap32(a[4 * i + 3]);
#pragma unroll
                for (int i = 0; i < 4; ++i) {
                    const float own = 2.0f * (a[4 * i] + a[4 * i + 1] + a[4 * i + 2]) + a[4 * i + 3];
                    const float prev = hi ? rcv[i] : (i == 0 ? carry3 : rcv[i - 1]);
                    myimp[8 * t + 2 * i + hi] = own + prev;
                }
                carry3 = rcv[3];
#pragma unroll
                for (int ks = 0; ks < 2; ++ks) {
                    const bf16x8 pbk = pack8(a[8 * ks], a[8 * ks + 1], a[8 * ks + 2], a[8 * ks + 3], a[8 * ks + 4], a[8 * ks + 5], a[8 * ks + 6], a[8 * ks + 7]);
                    const LAS unsigned char* v0p = vcl + t * 64 + ks * 32;
                    const s16x4 a0 = *(const LAS s16x4*)v0p, a1 = *(const LAS s16x4*)(v0p + 16), c0 = *(const LAS s16x4*)(v0p + 32 * CMPV_PITCH), c1 = *(const LAS s16x4*)(v0p + 32 * CMPV_PITCH + 16);
                    const bf16x8 v0 = __builtin_shufflevector(a0, a1, 0, 1, 2, 3, 4, 5, 6, 7);
                    const bf16x8 v1 = __builtin_shufflevector(c0, c1, 0, 1, 2, 3, 4, 5, 6, 7);
                    out0 = MFMA32(v0, pbk, out0); out1 = MFMA32(v1, pbk, out1);
                }
            }
            const float gc = gate_c;
#pragma unroll
            for (int r = 0; r < 16; ++r) { oacc[r * 64] = out0[r] * gc; oacc[(16 + r) * 64] = out1[r] * gc; }
        }
        __syncthreads();
        SECT(0);
        for (int idx = tid; idx < 64 * 32; idx += 512) { const int q = idx >> 5, jj = idx & 31; LAS float* a = impw + q * 33 + jj;
            a[0] = (a[0] + a[64 * 33]) + (a[2 * 64 * 33] + a[3 * 64 * 33]); }
        __syncthreads();
        if (qt + 1 <= 8) { if (tid < 64) selm[tid] = (1u << (qt + 1)) - 1u; }
        else {
#pragma unroll 1
            for (int it = 0; it < 4; ++it) {
                const int q = 8 * w + 2 * it + hi, jj = r32;
                const LAS float* rowp = impw + q * 33;
                const float my = rowp[jj]; int cnt = 0;
                float rv[32];
#pragma unroll
                for (int j2 = 0; j2 < 32; ++j2) rv[j2] = rowp[j2];
#pragma unroll
                for (int j2 = 1; j2 < 31; ++j2) cnt += (j2 <= qt - 2 && (rv[j2] > my || (rv[j2] == my && j2 < jj))) ? 1 : 0;
                const bool forced = (jj == 0) || (jj == qt) || (jj == qt - 1);
                const bool cand = (jj >= 1) && (jj <= qt - 2);
                const bool sel = forced || (cand && cnt < 5);
                const unsigned long long bal = __ballot(sel);
                if (r32 == 0) selm[q] = hi ? (unsigned)(bal >> 32) : (unsigned)bal;
            }
        }
        __syncthreads();
        const unsigned mysel = selm[tb * 32 + r32];
        unsigned uni = selm[lane];
#pragma unroll
        for (int o = 1; o < 64; o <<= 1) uni |= __shfl_xor(uni, o);
        uni = __builtin_amdgcn_readfirstlane(uni);
        LAS unsigned char* qrl = lds + IMP_OFF + w * 4096 + lane * 16;
#pragma unroll
        for (int d0 = 0; d0 < 4; ++d0) *(LAS bf16x8*)(qrl + d0 * 1024) = qr[d0];
        SECT(1);
        {
            AttnState st; st.m = 0.f; st.l = 0.f;
#pragma unroll
            for (int r = 0; r < 16; ++r) { st.o0[r] = 0.f; st.o1[r] = 0.f; }
            const int jlo = qt >= 8 ? qt - 8 : 0;
            const unsigned tilesW = (unsigned)(((1ull << (qt + 1)) - 1ull) & ~((1ull << jlo) - 1ull));
            nsa_tiles(st, lds, uni, tilesW, kvbase, mysel, slope2, tq, qt, lane, w, kreg0, vreg0, gate_s);
            SECT(2);
            int l2 = lane; asm volatile("" : "+v"(l2)); const size_t row2 = (size_t)b * SEQ + 64 * qt + 32 * tb + (l2 & 31); LAS float* oacc2 = (LAS float*)(lds + OACC_OFF) + w * 2048 + l2;
            const float lt = st.l + swap32(st.l); const float sc = gate_w / lt;
            f32x16 out0, out1;
#pragma unroll
            for (int r = 0; r < 16; ++r) { out0[r] = oacc2[r * 64] + st.o0[r] * sc; out1[r] = oacc2[(16 + r) * 64] + st.o1[r] * sc; }
          bf16* op = obuf + row2 * DM + head * 64 + 4 * (l2 >> 5);
#pragma unroll
          for (int i = 0; i < 4; ++i) {
            u32x2 w0; w0.x = pk2(out0[4 * i], out0[4 * i + 1]); w0.y = pk2(out0[4 * i + 2], out0[4 * i + 3]); *(u32x2*)(op + 8 * i) = w0;
            u32x2 w1; w1.x = pk2(out1[4 * i], out1[4 * i + 1]); w1.y = pk2(out1[4 * i + 2], out1[4 * i + 3]); *(u32x2*)(op + 32 + 8 * i) = w1; } }
        SECT(3);
    }
}
__device__ __forceinline__ void sb_attn_phase(const Params& p, LAS unsigned char* lds, int G) {
    int tid_ = threadIdx.x; asm volatile("" : "+v"(tid_)); const int tid = tid_, lane = tid & 63, w = __builtin_amdgcn_readfirstlane(tid >> 6), r32 = lane & 31, hi = lane >> 5;
    unsigned char* ws = p.ws;
    const bf16* proj = (const bf16*)(ws + WS_PROJ);
    bf16* obuf = (bf16*)(ws + WS_O);
    LAS unsigned char* vl = lds + w * 4096;
    const LAS unsigned char* vp = vl + (4 * hi + ((lane & 15) >> 2)) * 64 + ((lane >> 4) & 1) * 32 + (lane & 3) * 8;
    const int gw = blockIdx.x * 8 + w, NGW = G * 8;
    for (int u = gw; u < NB * NH * 64; u += NGW) {
        const int qb = u & 63, head = (u >> 6) & 15, b = u >> 10;
        const int tq = 32 * qb + r32; const size_t row = (size_t)b * SEQ + tq;
        bf16x8 qr[4];
        { const bf16* qp = proj + row * SB_P + head * 64 + hi * 8;
#pragma unroll
          for (int d0 = 0; d0 < 4; ++d0) qr[d0] = *(const bf16x8*)(qp + d0 * 16); }
        const bf16* kbase = proj + (size_t)b * SEQ * SB_P + 1024 + head * 64;
        const bf16* vbase = proj + (size_t)b * SEQ * SB_P + 2048 + head * 64;
        f32x16 o0, o1;
#pragma unroll
        for (int r = 0; r < 16; ++r) { o0[r] = 0.f; o1[r] = 0.f; }
        float carry = 0.f;
        u32x4 vrA[4], vrB[4]; bf16x8 kfA[4], kfB[4];
#define SB_LOAD(VR, KF, kt_) do { const int key0_ = 32 * (kt_); \
            _Pragma("unroll") for (int i = 0; i < 4; ++i) { const int idx = i * 64 + lane, db = idx >> 7, key = (idx >> 2) & 31, c4 = idx & 3; \
                VR[i] = *(const u32x4*)(vbase + (size_t)(key0_ + key) * SB_P + 32 * db + 8 * c4); } \
            _Pragma("unroll") for (int d0 = 0; d0 < 4; ++d0) KF[d0] = *(const bf16x8*)(kbase + (size_t)(key0_ + r32) * SB_P + d0 * 16 + hi * 8); } while (0)
#define SB_TILE(VR, KF, kt_, DG) do { const int key0 = 32 * (kt_); \
            f32x16 z; \
            _Pragma("unroll") for (int r = 0; r < 16; ++r) z[r] = 0.f; \
            _Pragma("unroll") for (int d0 = 0; d0 < 4; ++d0) z = MFMA32(KF[d0], qr[d0], z); \
            LDS_FENCE(); \
            _Pragma("unroll") for (int i = 0; i < 4; ++i) *(LAS u32x4*)(vl + (i * 64 + lane) * 16) = VR[i]; \
              \
            float L[16]; \
            _Pragma("unroll") for (int r = 0; r < 16; ++r) { \
                const float zz = z[r]; \
                const float sp = fmaxf(zz, 0.f) + __builtin_amdgcn_logf(1.0f + __builtin_amdgcn_exp2f(-fabsf(zz))); \
                L[r] = (!(DG) || (key0 + crow(r, hi)) < tq) ? -sp : 0.f; } \
            float gsum[4], og[4], T[4]; \
            _Pragma("unroll") for (int i = 0; i < 4; ++i) { gsum[i] = (L[4 * i] + L[4 * i + 1]) + (L[4 * i + 2] + L[4 * i + 3]); og[i] = swap32(gsum[i]); T[i] = gsum[i] + og[i]; } \
            float R[4]; R[3] = 0.f; R[2] = T[3]; R[1] = T[3] + T[2]; R[0] = R[1] + T[1]; \
            float a[16]; \
            _Pragma("unroll") for (int i = 0; i < 4; ++i) { \
                const float A = carry + R[i] + (hi ? 0.f : og[i]); \
                const float s3 = A, s2 = s3 + L[4 * i + 3], s1 = s2 + L[4 * i + 2], s0 = s1 + L[4 * i + 1]; \
                const float suf[4] = {s0, s1, s2, s3}; \
                _Pragma("unroll") for (int e4 = 0; e4 < 4; ++e4) { const int r = 4 * i + e4; const float ev = __builtin_amdgcn_exp2f(z[r] + L[r] + suf[e4]); \
                    a[r] = (!(DG) || (key0 + crow(r, hi)) < tq) ? ev : 0.f; } } \
            carry += R[0] + T[0]; \
            const bf16x8 pb0 = pack8(a[0], a[1], a[2], a[3], a[4], a[5], a[6], a[7]), pb1 = pack8(a[8], a[9], a[10], a[11], a[12], a[13], a[14], a[15]); \
            LDS_FENCE(); \
            _Pragma("unroll") for (int ks = 0; ks < 2; ++ks) { \
                const s16x4 a0 = vtr(vp + ks * 1024), a1 = vtr(vp + ks * 1024 + 512), c0 = vtr(vp + 2048 + ks * 1024), c1 = vtr(vp + 2048 + ks * 1024 + 512); \
                const bf16x8 v0 = __builtin_shufflevector(a0, a1, 0, 1, 2, 3, 4, 5, 6, 7); \
                const bf16x8 v1 = __builtin_shufflevector(c0, c1, 0, 1, 2, 3, 4, 5, 6, 7); \
                o0 = MFMA32(v0, ks ? pb1 : pb0, o0); o1 = MFMA32(v1, ks ? pb1 : pb0, o1); } } while (0)
#define SB_DONE(kt_) ((kt_) == 0 || __all(carry < -30.0f))
        SB_LOAD(vrA, kfA, qb);
        if (qb > 0) SB_LOAD(vrB, kfB, qb - 1);
        SB_TILE(vrA, kfA, qb, 1);
        if (!SB_DONE(qb)) {
            for (int kt = qb - 1;;) {
                if (kt > 0) SB_LOAD(vrA, kfA, kt - 1);
                SB_TILE(vrB, kfB, kt, 0);
                if (SB_DONE(kt)) break;
                --kt;
                if (kt > 0) SB_LOAD(vrB, kfB, kt - 1);
                SB_TILE(vrA, kfA, kt, 0);
                if (SB_DONE(kt)) break;
                --kt;
            }
        }
#undef SB_DONE
#undef SB_LOAD
#undef SB_TILE
        LDS_FENCE();
        { bf16* op = obuf + row * DM + head * 64 + 4 * hi;
#pragma unroll
          for (int i = 0; i < 4; ++i) {
            u32x2 w0; w0.x = pk2(o0[4 * i], o0[4 * i + 1]); w0.y = pk2(o0[4 * i + 2], o0[4 * i + 3]); *(u32x2*)(op + 8 * i) = w0;
            u32x2 w1; w1.x = pk2(o1[4 * i], o1[4 * i + 1]); w1.y = pk2(o1[4 * i + 2], o1[4 * i + 3]); *(u32x2*)(op + 32 + 8 * i) = w1; } }
    }
}

__device__ __forceinline__ void final_norm_phase(const Params& p, int G) {
    int tid_ = threadIdx.x; asm volatile("" : "+v"(tid_));
    const int lane = tid_ & 63, gw = blockIdx.x * 8 + __builtin_amdgcn_readfirstlane(tid_ >> 6), NGW = G * 8;
    const float* ss = (const float*)(p.ws + WS_SS); const float* g = p.in[3]; const bf16* hb = (const bf16*)(p.ws + WS_HB);
    f32x4 gv[4];
#pragma unroll
    for (int j = 0; j < 4; ++j) gv[j] = *((const f32x4*)g + lane + 64 * j);
    for (int m0 = gw * 2; m0 < MTOK; m0 += NGW * 2) {
        u32x2 hv[2][4]; float rs[2];
#pragma unroll
        for (int q = 0; q < 2; ++q) { rs[q] = pg8::row_rstd(ss, m0 + q);
#pragma unroll
          for (int j = 0; j < 4; ++j) hv[q][j] = *((const u32x2*)(hb + (size_t)(m0 + q) * DM) + lane + 64 * j); }
#pragma unroll
        for (int q = 0; q < 2; ++q) { f32x4* xr = (f32x4*)(p.out + (size_t)(m0 + q) * DM) + lane;
#pragma unroll
          for (int j = 0; j < 4; ++j) { f32x4 v; v[0] = __builtin_bit_cast(float, hv[q][j].x << 16); v[1] = __builtin_bit_cast(float, hv[q][j].x & 0xffff0000u);
            v[2] = __builtin_bit_cast(float, hv[q][j].y << 16); v[3] = __builtin_bit_cast(float, hv[q][j].y & 0xffff0000u); xr[64 * j] = v * rs[q] * gv[j]; } }
    }
}

#define XB_TMO      128
#define XB_XCNT(j)  (256  + 64 * (j))
#define XB_XSUB(j)  (1280 + 64 * (j))
#define XB_XGEN(j)  (2304 + 64 * (j))
#define XB_TOP      3328
#define XB_TOPGEN   3392
#define XCD_BAR_WORDS 3456
#define XB_SPIN_CAP (1u << 18)

__device__ __forceinline__ unsigned xb_ld(unsigned* p)              { return __hip_atomic_load(p, __ATOMIC_RELAXED, __HIP_MEMORY_SCOPE_AGENT); }
__device__ __forceinline__ unsigned xb_add(unsigned* p, unsigned v) { return __hip_atomic_fetch_add(p, v, __ATOMIC_RELAXED, __HIP_MEMORY_SCOPE_AGENT); }
__device__ __forceinline__ unsigned xb_xcc_id() { return (unsigned)__builtin_amdgcn_s_getreg((3 << 11) | 20) & 0xFu; }
#define XB_SPIN(cond, bar) do { unsigned _sp = 0; while (cond) { __builtin_amdgcn_s_sleep(1); \
    if ((++_sp & 255u) == 0u) { if (xb_ld(&(bar)[XB_TMO])) break; if (_sp > XB_SPIN_CAP) { atomicAdd(&(bar)[XB_TMO], 1u); break; } } } } while (0)

struct XcdBarrier {
    unsigned* bar; unsigned x;
    volatile LAS unsigned* st;
};

__device__ __forceinline__ XcdBarrier xcd_barrier_post(unsigned* bar, volatile LAS unsigned* st) {
    XcdBarrier b; b.bar = bar; b.x = xb_xcc_id(); b.st = st;
    if (threadIdx.x == 0) (void)xb_add(&bar[XB_XCNT(b.x)], 1u);
    return b;
}
__device__ __forceinline__ void xcd_barrier_complete(unsigned* bar, unsigned x, unsigned& nloc, unsigned& nx) {
    const unsigned G = gridDim.x * gridDim.y * gridDim.z;
    unsigned sum, cnt, mine, sp = 0u;
    for (;;) {
        sum = 0u; cnt = 0u; mine = 0u;
#pragma unroll
        for (unsigned j = 0; j < 16; ++j) { const unsigned c = xb_ld(&bar[XB_XCNT(j)]); sum += c; cnt += (c > 0u) ? 1u : 0u; mine = (j == x) ? c : mine; }
        if (sum == G) break;
        __builtin_amdgcn_s_sleep(1);
        if ((++sp & 255u) == 0u) { if (xb_ld(&bar[XB_TMO])) break; if (sp > XB_SPIN_CAP) { atomicAdd(&bar[XB_TMO], 1u); break; } }
    }
    nloc = mine > 0u ? mine : 1u; nx = cnt > 0u ? cnt : 1u;
}

__device__ __forceinline__ void xcd_barrier(const XcdBarrier& b) {
    asm volatile("s_waitcnt vmcnt(0)" ::: "memory");
    __syncthreads();
    if (threadIdx.x == 0) {
        unsigned* bar = b.bar;
        __builtin_amdgcn_s_waitcnt(0);
        unsigned nloc = b.st[0], nx = b.st[1];
        if (nloc == 0u) { xcd_barrier_complete(bar, b.x, nloc, nx); b.st[0] = nloc; b.st[1] = nx; }
        const unsigned old = xb_add(&bar[XB_XSUB(b.x)], 1u);
        const unsigned gen = old / nloc;
        if (old + 1u == (gen + 1u) * nloc) {
            __builtin_amdgcn_fence(__ATOMIC_RELEASE, "agent");
            asm volatile("s_waitcnt vmcnt(0)" ::: "memory");
            const unsigned og = xb_add(&bar[XB_TOP], 1u);
            const unsigned tg = og / nx;
            if (og + 1u == (tg + 1u) * nx) xb_add(&bar[XB_TOPGEN], 1u);
            else XB_SPIN(xb_ld(&bar[XB_TOPGEN]) == tg, bar);
            __builtin_amdgcn_fence(__ATOMIC_ACQUIRE, "agent");
            xb_add(&bar[XB_XGEN(b.x)], 1u);
            asm volatile("s_waitcnt vmcnt(0)" ::: "memory");
        } else {
            XB_SPIN(xb_ld(&bar[XB_XGEN(b.x)]) == gen, bar);
            __builtin_amdgcn_fence(__ATOMIC_ACQUIRE, "agent");
            asm volatile("s_waitcnt vmcnt(0)" ::: "memory");
        }
    }
    __syncthreads();
}

__global__ void __launch_bounds__(512, 2) mega(Params p) {
    extern __shared__ __attribute__((aligned(16))) unsigned char lds_raw[];
    LAS unsigned char* lds = (LAS unsigned char*)lds_raw;
    cg::grid_group grid = cg::this_grid();
    const int G = gridDim.x;
    unsigned char* ws = p.ws;
    bf16* hb = (bf16*)(ws + WS_HB); bf16* proj = (bf16*)(ws + WS_PROJ); bf16* obuf = (bf16*)(ws + WS_O);
    float* ss = (float*)(ws + WS_SS); float* gates = (float*)(ws + WS_GATES);
    volatile LAS unsigned* bst = (volatile LAS unsigned*)(lds + 147456 + 768);
    if (threadIdx.x < 2) bst[threadIdx.x] = 0u;
    if (threadIdx.x < 8) ((LAS unsigned long long*)(lds + 147456 + 800))[threadIdx.x] = 0ull;
    __syncthreads();
    XcdBarrier bar = xcd_barrier_post((unsigned*)(ws + WS_CTL), bst);
    int ph = 0;
    LAS unsigned long long* tsl = (LAS unsigned long long*)(lds + 147456);
    LAS int* kindl = (LAS int*)(lds + 147456 + 512);
    const bool stamper = (TSEL >= 0) && blockIdx.x == 0 && threadIdx.x == 0;
    if (stamper) tsl[0] = __builtin_amdgcn_s_memrealtime();
#define PHASE_ON (ph >= p.ph_lo && ph < p.ph_hi)
#define PHASE_END(kind) do { if (ph >= p.ph_lo && ph + 1 < p.ph_hi) { if (ph == 0) grid.sync(); else xcd_barrier(bar); } if (stamper) { tsl[ph + 1] = __builtin_amdgcn_s_memrealtime(); kindl[ph] = (kind); } ++ph; } while (0)
    if (PHASE_ON) prologue(p, lds, G);
    PHASE_END(0);
#pragma unroll 1
    for (int i = 0; i < 4; ++i) {
        const bool nsa = !(i & 1); const int j = i >> 1;
        if (PHASE_ON) {
            const bf16* Wt = nsa ? (const bf16*)(ws + WS_WNSA) + (size_t)j * NSA_P * DM : (const bf16*)(ws + WS_WSB) + (size_t)j * SB_P * DM;
            const int N = nsa ? NSA_P : SB_P;
            pg8::Gemm g{hb, Wt, MTOK, N, DM}; pg8::StaticOrder S; S.init(MTOK, N, G, (int)blockIdx.x);
            pg8::EpiProj E{proj, N, ss, p.in[5] + j * 48, gates, nsa ? 2560 : (1 << 30)};
            pg8::gemm_phase<pg8::EpiProj, pg8::StaticOrder, true, true>(lds, g, S, E);
        }
        PHASE_END(1);
        if (nsa) {
            if (PHASE_ON) compress_phase(p, lds, G, j);
            PHASE_END(2);
            if (PHASE_ON) nsa_attn_phase(p, lds, G);
            PHASE_END(3);
        } else {
            if (PHASE_ON) sb_attn_phase(p, lds, G);
            PHASE_END(4);
        }
#pragma unroll 1
        for (int s = 0; s < 2; ++s) {
            if (PHASE_ON) {
                const bf16* A = s == 0 ? obuf : proj;
                const bf16* Wt = s == 0 ? (const bf16*)(ws + WS_WOUT) + (size_t)i * DM * DM : (const bf16*)(ws + WS_W2) + (size_t)i * DM * DFF;
                pg8::Gemm g{A, Wt, MTOK, DM, s == 0 ? DM : DFF}; pg8::StaticOrder S; S.init(MTOK, DM, G, (int)blockIdx.x);
                pg8::EpiResid E{hb, ss};
                pg8::gemm_phase<pg8::EpiResid, pg8::StaticOrder, true, true>(lds, g, S, E);
            }
            PHASE_END(5);
            if (s == 0) {
                if (PHASE_ON) {
                    pg8::Gemm g{hb, (const bf16*)(ws + WS_W13) + (size_t)i * DFF2 * DM, MTOK, DFF2, DM}; pg8::StaticOrder S; S.init(MTOK, DFF2, G, (int)blockIdx.x);
                    pg8::EpiSwiGLU E{proj, ss};
                    pg8::gemm_phase<pg8::EpiSwiGLU, pg8::StaticOrder, true, true>(lds, g, S, E);
                }
                PHASE_END(6);
            }
        }
    }
    if (TSEL == 8) { for (int q = 0; q < 10; ++q) { PHASE_END(8); } }
    if (PHASE_ON) final_norm_phase(p, G);
    if (TSEL >= 0) {
        grid.sync();
        if (stamper) { tsl[ph + 1] = __builtin_amdgcn_s_memrealtime(); kindl[ph] = 7; }
        if (blockIdx.x == 0) {
            __syncthreads();
            unsigned long long T = 0;
            for (int k = 0; k <= ph; ++k) if (kindl[k] == TSEL) T += tsl[k + 1] - tsl[k];
            if (TSEL >= 9) T = ((LAS unsigned long long*)(lds + 147456 + 800))[TSEL - 9];
            const int K = (int)(T / 100);
            for (int r = threadIdx.x; r < K && r < MTOK; r += 512) p.out[(size_t)r * DM + 7] += 0.1f;
        }
    }
}

extern "C" void kernel_launch(void* const* d_in, const int* in_sizes, int n_in, void* d_out, int out_size, void* d_ws, size_t ws_size, hipStream_t stream) {
    static int grid = 0;
    if (grid == 0) {
        if (n_in != 15 || out_size != MTOK * DM || ws_size < WS_END) { fprintf(stderr, "kernel_launch: unexpected shapes (n_in %d out %d ws %zu)\n", n_in, out_size, ws_size); grid = -1; return; }
        int dev = 0, cus = 0, per_cu = 0;
        if (hipGetDevice(&dev) != hipSuccess || hipDeviceGetAttribute(&cus, hipDeviceAttributeMultiprocessorCount, dev) != hipSuccess) { grid = -1; return; }
        if (hipFuncSetAttribute((const void*)mega, hipFuncAttributeMaxDynamicSharedMemorySize, LDS_BYTES) != hipSuccess) { fprintf(stderr, "hipFuncSetAttribute failed\n"); grid = -1; return; }
        if (hipOccupancyMaxActiveBlocksPerMultiprocessor(&per_cu, mega, 512, LDS_BYTES) != hipSuccess || per_cu < 1) { fprintf(stderr, "occupancy query failed\n"); grid = -1; return; }
        grid = cus;
    }
    if (grid <= 0) return;
    Params p{};
    for (int i = 0; i < 15; ++i) p.in[i] = (const float*)d_in[i];
    p.out = (float*)d_out; p.ws = (unsigned char*)d_ws; p.ph_lo = 0; p.ph_hi = 1000;
    if (hipMemsetAsync((unsigned char*)d_ws + WS_CTL, 0, XCD_BAR_WORDS * sizeof(unsigned), stream) != hipSuccess) { fprintf(stderr, "memset failed\n"); return; }
    void* args[] = {&p};
    hipError_t e = hipLaunchCooperativeKernel((void*)mega, dim3(grid), dim3(512), args, LDS_BYTES, stream);
    if (e != hipSuccess) fprintf(stderr, "cooperative launch failed: %s (grid %d)\n", hipGetErrorString(e), grid);
}
```

```cpp
#include <hip/hip_runtime.h>
#include <hip/hip_cooperative_groups.h>
#include <cstdio>
#include <cstdint>
#include <cmath>
namespace cg = cooperative_groups;
namespace pg8 {
#define PG8_LAS __attribute__((address_space(3)))
typedef unsigned short bf16_t;
typedef short bf16x8 __attribute__((ext_vector_type(8)));
typedef float f32x4 __attribute__((ext_vector_type(4)));
typedef unsigned u32x4 __attribute__((ext_vector_type(4)));
constexpr int BM = 256, BK = 64, HALF = 128, HTB = HALF * BK * 2  , STAGE_BYTES = 8 * HTB, NXCD = 8, WGM = 8;

__host__ __device__ __forceinline__ int lds_byte(int r, int c) { const int st = (r >> 4) * 2 + (c >> 5), rr = r & 15, cc = c & 31, ob = rr * 64 + cc * 2; return st * 1024 + (ob ^ (((ob >> 9) & 1) << 5)); }
__host__ __device__ __forceinline__ void stage_rc(int b, int& R, int& C) { const int st = b / 1024, sb = b % 1024, swz = sb ^ (((sb >> 9) & 1) << 5); R = (st >> 1) * 16 + swz / 64; C = (st & 1) * 32 + (swz % 64) / 2; }
__host__ __device__ __forceinline__ int perm32(int rho) { const int n = rho >> 4, i = rho & 15; return 8 * (i >> 2) + 4 * n + (i & 3); }

struct Unit { int pm, pn; };
struct Gemm { const bf16_t* A; const bf16_t* Bt; int M, N, K; };

struct StaticOrder {
    int nM, nN, nwg, G, c;
    __host__ __device__ void init(int M, int N, int G_, int c_) { nM = M / BM; nN = N / BM; nwg = nM * nN; G = G_; c = c_; }
    __host__ __device__ bool next(int i, Unit& u) const {
        const long L = (long)i * G + c; if (L >= nwg) return false;
        int wgid = (int)L; { const int q = nwg / NXCD, r = nwg % NXCD, xcd = wgid % NXCD, off = wgid / NXCD; wgid = (xcd < r ? xcd * (q + 1) : r * (q + 1) + (xcd - r) * q) + off; }
        const int nig = WGM * nN, gid = wgid / nig, fm = gid * WGM, gsz = (nM - fm) < WGM ? (nM - fm) : WGM;
        u.pm = fm + ((wgid % nig) % gsz); u.pn = (wgid % nig) / gsz; return true;
    }
    __device__ __forceinline__ void a_ready(const Unit&) const {}
    __device__ __forceinline__ void done(const Unit&) const {}
};

__device__ __forceinline__ unsigned cvt_pk_bf16(float lo, float hi) { unsigned r; asm volatile("v_cvt_pk_bf16_f32 %0, %1, %2" : "=v"(r) : "v"(lo), "v"(hi)); return r; }
typedef unsigned u32x4 __attribute__((ext_vector_type(4)));
typedef float f32x2 __attribute__((ext_vector_type(2)));
__device__ __forceinline__ float row_rstd(const float* ss, int row) {
    const f32x4* p = (const f32x4*)(ss + (size_t)row * 16);
    const f32x4 a = p[0], b = p[1], c = p[2], d = p[3];
    const float s = (((a[0] + a[1]) + (a[2] + a[3])) + ((b[0] + b[1]) + (b[2] + b[3]))) + (((c[0] + c[1]) + (c[2] + c[3])) + ((d[0] + d[1]) + (d[2] + d[3])));
    return rsqrtf(s * (1.0f / 1024.0f) + 1e-6f);
}
__device__ __forceinline__ void rows_rstd8(const float* ss, int row0, int fq, float (&rs)[2][4]) {
    f32x4 v[2][4];
#pragma unroll
    for (int ai = 0; ai < 2; ++ai)
#pragma unroll
        for (int m = 0; m < 4; ++m) v[ai][m] = *(const f32x4*)(ss + (size_t)(row0 + ai * HALF + m * 16) * 16 + 4 * fq);
#pragma unroll
    for (int ai = 0; ai < 2; ++ai)
#pragma unroll
        for (int m = 0; m < 4; ++m) { float t = (v[ai][m][0] + v[ai][m][1]) + (v[ai][m][2] + v[ai][m][3]); t += __shfl_xor(t, 16); t += __shfl_xor(t, 32); rs[ai][m] = rsqrtf(t * (1.0f / 1024.0f) + 1e-6f); }
}
struct EpiProj {
    static constexpr bool PERM = true, AFTER_DRAIN = false;
    bf16_t* O; int ldc; const float* ss; const float* gate_b; float* gates; int gate_col0;
    __device__ __forceinline__ void operator()(const f32x4 (&acc)[2][2][4][2], const Unit& u, int wr, int wc, int fr, int fq) const {
        const int row0 = u.pm * BM + wr * 64 + fr, col0 = u.pn * BM + wc * 32 + 8 * fq;
        float rsv[2][4]; rows_rstd8(ss, row0, fq, rsv);
#pragma unroll
        for (int ai = 0; ai < 2; ++ai)
#pragma unroll
            for (int m = 0; m < 4; ++m) {
                const int row = row0 + ai * HALF + m * 16; const float rs = rsv[ai][m];
#pragma unroll
                for (int bj = 0; bj < 2; ++bj) {
                    const int col = col0 + bj * HALF;
                    const f32x4 v0 = acc[ai][bj][m][0] * rs, v1 = acc[ai][bj][m][1] * rs;
                    if (col >= gate_col0) {
                        if (col < gate_col0 + 48) {
                            const int gc = col - gate_col0; const f32x4 b0 = *(const f32x4*)(gate_b + gc), b1 = *(const f32x4*)(gate_b + gc + 4);
                            f32x4 g0, g1;
#pragma unroll
                            for (int k = 0; k < 4; ++k) { g0[k] = 1.0f / (1.0f + __expf(-(v0[k] + b0[k]))); g1[k] = 1.0f / (1.0f + __expf(-(v1[k] + b1[k]))); }
                            *(f32x4*)(gates + (size_t)row * 48 + gc) = g0; *(f32x4*)(gates + (size_t)row * 48 + gc + 4) = g1;
                        }
                    } else {
                        u32x4 w; w.x = cvt_pk_bf16(v0[0], v0[1]); w.y = cvt_pk_bf16(v0[2], v0[3]); w.z = cvt_pk_bf16(v1[0], v1[1]); w.w = cvt_pk_bf16(v1[2], v1[3]);
                        *(u32x4*)(O + (size_t)row * ldc + col) = w;
                    }
                }
            }
    }
};
struct EpiResid {
    static constexpr bool PERM = true, AFTER_DRAIN = false;
    bf16_t* hb; float* ss;
    __device__ __forceinline__ void operator()(const f32x4 (&acc)[2][2][4][2], const Unit& u, int wr, int wc, int fr, int fq) const {
        const int row0 = u.pm * BM + wr * 64 + fr, col0 = u.pn * BM + wc * 32 + 8 * fq;
        u32x4 bq[2][4][2];
#pragma unroll
        for (int ai = 0; ai < 2; ++ai)
#pragma unroll
            for (int m = 0; m < 4; ++m)
#pragma unroll
                for (int bj = 0; bj < 2; ++bj) if (ai == 0 || m < 2) bq[ai][m][bj] = *(const u32x4*)(hb + (size_t)(row0 + ai * HALF + m * 16) * 1024 + col0 + bj * HALF);
#pragma unroll
        for (int ai = 0; ai < 2; ++ai)
#pragma unroll
            for (int m = 0; m < 4; ++m) {
                if (ai == 1 && m == 0) {
#pragma unroll
                    for (int m2 = 2; m2 < 4; ++m2)
#pragma unroll
                        for (int bj = 0; bj < 2; ++bj) bq[1][m2][bj] = *(const u32x4*)(hb + (size_t)(row0 + HALF + m2 * 16) * 1024 + col0 + bj * HALF);
                }
                const int row = row0 + ai * HALF + m * 16; float sq = 0.f;
#pragma unroll
                for (int bj = 0; bj < 2; ++bj) {
                    const u32x4 b = bq[ai][m][bj];
                    f32x4 v0, v1;
                    v0[0] = __builtin_bit_cast(float, b.x << 16) + acc[ai][bj][m][0][0]; v0[1] = __builtin_bit_cast(float, b.x & 0xffff0000u) + acc[ai][bj][m][0][1];
                    v0[2] = __builtin_bit_cast(float, b.y << 16) + acc[ai][bj][m][0][2]; v0[3] = __builtin_bit_cast(float, b.y & 0xffff0000u) + acc[ai][bj][m][0][3];
                    v1[0] = __builtin_bit_cast(float, b.z << 16) + acc[ai][bj][m][1][0]; v1[1] = __builtin_bit_cast(float, b.z & 0xffff0000u) + acc[ai][bj][m][1][1];
                    v1[2] = __builtin_bit_cast(float, b.w << 16) + acc[ai][bj][m][1][2]; v1[3] = __builtin_bit_cast(float, b.w & 0xffff0000u) + acc[ai][bj][m][1][3];
                    u32x4 w; w.x = cvt_pk_bf16(v0[0], v0[1]); w.y = cvt_pk_bf16(v0[2], v0[3]); w.z = cvt_pk_bf16(v1[0], v1[1]); w.w = cvt_pk_bf16(v1[2], v1[3]);
                    *(u32x4*)(hb + (size_t)row * 1024 + col0 + bj * HALF) = w;
                    sq += ((v0[0] * v0[0] + v0[1] * v0[1]) + (v0[2] * v0[2] + v0[3] * v0[3])) + ((v1[0] * v1[0] + v1[1] * v1[1]) + (v1[2] * v1[2] + v1[3] * v1[3]));
                }
                sq += __shfl_xor(sq, 16); sq += __shfl_xor(sq, 32);
                if (fq == 0) ss[(size_t)row * 16 + u.pn * 4 + wc] = sq;
            }
    }
};
struct EpiSwiGLU {
    static constexpr bool PERM = true, AFTER_DRAIN = false;
    bf16_t* O; const float* ss;
    __device__ __forceinline__ void operator()(const f32x4 (&acc)[2][2][4][2], const Unit& u, int wr, int wc, int fr, int fq) const {
        const int row0 = u.pm * BM + wr * 64 + fr, col = u.pn * HALF + wc * 32 + 8 * fq;
        float rsv[2][4]; rows_rstd8(ss, row0, fq, rsv);
#pragma unroll
        for (int ai = 0; ai < 2; ++ai)
#pragma unroll
            for (int m = 0; m < 4; ++m) {
                const int row = row0 + ai * HALF + m * 16; const float rs = rsv[ai][m];
                float o[8];
#pragma unroll
                for (int n = 0; n < 2; ++n)
#pragma unroll
                    for (int k = 0; k < 4; ++k) { const float a = acc[ai][0][m][n][k] * rs, b = acc[ai][1][m][n][k] * rs; o[n * 4 + k] = a * b * __builtin_amdgcn_rcpf(1.0f + __builtin_amdgcn_exp2f(-1.4426950408889634f * a)); }
                u32x4 w; w.x = cvt_pk_bf16(o[0], o[1]); w.y = cvt_pk_bf16(o[2], o[3]); w.z = cvt_pk_bf16(o[4], o[5]); w.w = cvt_pk_bf16(o[6], o[7]);
                *(u32x4*)(O + (size_t)row * 2816 + col) = w;
            }
    }
};
template <class Epi, class Sched, bool ALIGN_EPI = false, bool SP2 = false>
__device__ __forceinline__ void gemm_phase(PG8_LAS unsigned char* lds, const Gemm g, const Sched& S, const Epi& E) {
    int tid_ = threadIdx.x; asm volatile("" : "+v"(tid_)); const int tid = tid_, wid = __builtin_amdgcn_readfirstlane(tid >> 6), lane = tid & 63, wr = wid >> 2, wc = wid & 3, fr = lane & 15, fq = lane >> 4;
    const int K = g.K, nt = K / BK;
    unsigned voffA[2], voffB[2];
#pragma unroll
    for (int i = 0; i < 2; ++i) { int R, C; stage_rc(tid * 16 + i * 8192, R, C); const int Rb = Epi::PERM ? ((R & ~31) + perm32(R & 31)) : R;
        voffA[i] = (unsigned)(R * K + C) * 2u; voffB[i] = (unsigned)(Rb * K + C) * 2u; }
    const size_t kstep = (size_t)(BK * 2);
    const size_t hstep = (size_t)HALF * K * 2;
    const size_t tstep = 2 * hstep;
    const unsigned ldsw = (unsigned)wid * 1024u;
    const int aoff = lds_byte(wr * 64 + fr, fq * 8), boff = lds_byte(wc * 32 + fr, fq * 8);
#define PG8_SA(b, h) (((b) * 2 + (h)) * HTB)
#define PG8_SB(b, h) ((4 + (b) * 2 + (h)) * HTB)
#define PG8_STAGE(bufoff, gbase, voff) do { _Pragma("unroll") for (int _i = 0; _i < 2; ++_i) \
        __builtin_amdgcn_global_load_lds((const unsigned*)((const char*)(gbase) + (voff)[_i]), (PG8_LAS unsigned*)(lds + (bufoff) + ldsw + _i * 8192), 16, 0, 0); } while (0)
#define PG8_LDA(dst, b, h) do { _Pragma("unroll") for (int m = 0; m < 4; ++m) _Pragma("unroll") for (int k = 0; k < 2; ++k) dst[m][k] = *(const PG8_LAS bf16x8*)(lds + PG8_SA(b, h) + aoff + m * 2048 + k * 1024); } while (0)
#define PG8_LDB(dst, b, h) do { _Pragma("unroll") for (int n = 0; n < 2; ++n) _Pragma("unroll") for (int k = 0; k < 2; ++k) dst[n][k] = *(const PG8_LAS bf16x8*)(lds + PG8_SB(b, h) + boff + n * 2048 + k * 1024); } while (0)
#define PG8_MMA(ai, bj, At, Bt) do { __builtin_amdgcn_s_setprio(1); _Pragma("unroll") for (int m = 0; m < 4; ++m) _Pragma("unroll") for (int n = 0; n < 2; ++n) _Pragma("unroll") for (int k = 0; k < 2; ++k) \
        acc[ai][bj][m][n] = __builtin_amdgcn_mfma_f32_16x16x32_bf16(Bt[n][k], At[m][k], acc[ai][bj][m][n], 0, 0, 0); __builtin_amdgcn_s_setprio(0); } while (0)
#define PG8_WAIT_V(n) asm volatile("s_waitcnt vmcnt(" #n ")" ::: "memory")
#define PG8_WAIT_L(n) asm volatile("s_waitcnt lgkmcnt(" #n ")" ::: "memory")
#define PG8_BAR __builtin_amdgcn_s_barrier()
#define PG8_SCHED __builtin_amdgcn_sched_barrier(0)
    Unit cur, nxt; int ui = 0;
    if (!S.next(0, cur)) return;
    f32x4 acc[2][2][4][2];
#pragma unroll
    for (int a = 0; a < 2; ++a)
#pragma unroll
        for (int b = 0; b < 2; ++b)
#pragma unroll
            for (int m = 0; m < 4; ++m)
#pragma unroll
                for (int n = 0; n < 2; ++n) acc[a][b][m][n] = (f32x4){0.f, 0.f, 0.f, 0.f};
    bf16x8 At[4][2], B0[2][2], B1[2][2];
    const char* cA = (const char*)g.A + (size_t)cur.pm * tstep; const char* cB = (const char*)g.Bt + (size_t)cur.pn * tstep;
    S.a_ready(cur);
    if constexpr (SP2) {
        PG8_STAGE(PG8_SB(0, 0), cB, voffB); PG8_STAGE(PG8_SB(0, 1), cB + hstep, voffB); PG8_STAGE(PG8_SA(0, 0), cA, voffA); PG8_STAGE(PG8_SA(0, 1), cA + hstep, voffA);
        if (wr == 1) PG8_BAR;
        PG8_WAIT_V(2); PG8_BAR;
        PG8_STAGE(PG8_SB(1, 0), cB + kstep, voffB); PG8_STAGE(PG8_SA(1, 0), cA + kstep, voffA); PG8_STAGE(PG8_SB(1, 1), cB + hstep + kstep, voffB);
        PG8_WAIT_V(6); PG8_BAR;
    } else {
        PG8_STAGE(PG8_SB(0, 0), cB, voffB); PG8_STAGE(PG8_SA(0, 0), cA, voffA); PG8_STAGE(PG8_SB(0, 1), cB + hstep, voffB); PG8_STAGE(PG8_SA(0, 1), cA + hstep, voffA);
        if (wr == 1) PG8_BAR;
        PG8_WAIT_V(4); PG8_BAR;
        PG8_STAGE(PG8_SB(1, 0), cB + kstep, voffB); PG8_STAGE(PG8_SA(1, 0), cA + kstep, voffA); PG8_STAGE(PG8_SB(1, 1), cB + hstep + kstep, voffB);
        PG8_WAIT_V(6); PG8_BAR;
    }
    for (;;) {
        const bool has_next = S.next(ui + 1, nxt);
        const char* nA = has_next ? (const char*)g.A + (size_t)nxt.pm * tstep : cA; const char* nB = has_next ? (const char*)g.Bt + (size_t)nxt.pn * tstep : cB;
        for (int t = 0; t < nt; t += 2) {
            const bool last = (t == nt - 2);
            const char* a1 = cA + (size_t)(t + 1) * kstep;
            const char* a2 = last ? nA : cA + (size_t)(t + 2) * kstep; const char* b2 = last ? nB : cB + (size_t)(t + 2) * kstep;
            const char* a3 = a2 + kstep; const char* b3 = b2 + kstep;
            if (last && has_next) S.a_ready(nxt);
            if constexpr (SP2) {
            PG8_LDB(B0, 0, 0); PG8_LDB(B1, 0, 1); PG8_SCHED; PG8_LDA(At, 0, 0); PG8_STAGE(PG8_SA(1, 1), a1 + hstep, voffA);
            PG8_WAIT_V(8); PG8_WAIT_L(0); PG8_BAR; PG8_MMA(0, 0, At, B0); PG8_MMA(0, 1, At, B1); PG8_BAR; PG8_SCHED;
            PG8_LDA(At, 0, 1); PG8_STAGE(PG8_SB(0, 0), b2, voffB); PG8_STAGE(PG8_SB(0, 1), b2 + hstep, voffB); PG8_STAGE(PG8_SA(0, 0), a2, voffA);
            PG8_WAIT_V(8); PG8_WAIT_L(0); PG8_BAR; PG8_MMA(1, 0, At, B0); PG8_MMA(1, 1, At, B1); PG8_BAR; PG8_SCHED;
            PG8_LDB(B0, 1, 0); PG8_LDB(B1, 1, 1); PG8_SCHED; PG8_LDA(At, 1, 0); PG8_STAGE(PG8_SA(0, 1), a2 + hstep, voffA);
            PG8_WAIT_V(8); PG8_WAIT_L(0); PG8_BAR; PG8_MMA(0, 0, At, B0); PG8_MMA(0, 1, At, B1); PG8_BAR; PG8_SCHED;
            PG8_LDA(At, 1, 1); PG8_STAGE(PG8_SB(1, 0), b3, voffB); PG8_STAGE(PG8_SB(1, 1), b3 + hstep, voffB); PG8_STAGE(PG8_SA(1, 0), a3, voffA);
            PG8_WAIT_V(8); PG8_WAIT_L(0); PG8_BAR; PG8_MMA(1, 0, At, B0); PG8_MMA(1, 1, At, B1); PG8_BAR; PG8_SCHED;
            } else {
            PG8_LDB(B0, 0, 0); PG8_SCHED; PG8_LDA(At, 0, 0); PG8_STAGE(PG8_SA(1, 1), a1 + hstep, voffA);
            PG8_WAIT_L(8); PG8_BAR; PG8_WAIT_L(0); PG8_MMA(0, 0, At, B0); PG8_BAR; PG8_SCHED;
            PG8_LDB(B1, 0, 1); PG8_STAGE(PG8_SB(0, 0), b2, voffB);
            PG8_BAR; PG8_WAIT_L(0); PG8_MMA(0, 1, At, B1); PG8_BAR;
            PG8_LDA(At, 0, 1); PG8_STAGE(PG8_SA(0, 0), a2, voffA);
            PG8_BAR; PG8_WAIT_L(0); PG8_MMA(1, 0, At, B0); PG8_BAR; PG8_SCHED;
            PG8_STAGE(PG8_SB(0, 1), b2 + hstep, voffB);
            PG8_WAIT_V(6); PG8_BAR; PG8_MMA(1, 1, At, B1); PG8_BAR;
            PG8_LDB(B0, 1, 0); PG8_SCHED; PG8_LDA(At, 1, 0); PG8_STAGE(PG8_SA(0, 1), a2 + hstep, voffA);
            PG8_WAIT_L(8); PG8_BAR; PG8_WAIT_L(0); PG8_MMA(0, 0, At, B0); PG8_BAR; PG8_SCHED;
            PG8_LDB(B1, 1, 1); PG8_STAGE(PG8_SB(1, 0), b3, voffB);
            PG8_BAR; PG8_WAIT_L(0); PG8_MMA(0, 1, At, B1); PG8_BAR;
            PG8_LDA(At, 1, 1); PG8_STAGE(PG8_SA(1, 0), a3, voffA);
            PG8_BAR; PG8_WAIT_L(0); PG8_MMA(1, 0, At, B0); PG8_BAR; PG8_SCHED;
            PG8_STAGE(PG8_SB(1, 1), b3 + hstep, voffB);
            PG8_WAIT_V(6); PG8_BAR; PG8_MMA(1, 1, At, B1); PG8_BAR;
            }
        }
        if constexpr (ALIGN_EPI) { if (wr == 0) PG8_BAR; }
        if constexpr (!Epi::AFTER_DRAIN) { E(acc, cur, wr, wc, fr, fq); S.done(cur); }
        if (!has_next) break;
#pragma unroll
        for (int a = 0; a < 2; ++a)
#pragma unroll
            for (int b = 0; b < 2; ++b)
#pragma unroll
                for (int m = 0; m < 4; ++m)
#pragma unroll
                    for (int n = 0; n < 2; ++n) acc[a][b][m][n] = (f32x4){0.f, 0.f, 0.f, 0.f};
        cur = nxt; cA = nA; cB = nB; ++ui;
        if constexpr (ALIGN_EPI) { if (wr == 1) PG8_BAR; }
    }
    PG8_WAIT_V(0);
    if constexpr (!ALIGN_EPI) { if (wr == 0) PG8_BAR; }
    PG8_BAR;
    if constexpr (Epi::AFTER_DRAIN) { E.fused(acc, cur, wr, wc, fr, fq, lds, wid, lane); S.done(cur); }
#undef PG8_SA
#undef PG8_SB
#undef PG8_STAGE
#undef PG8_LDA
#undef PG8_LDB
#undef PG8_MMA
#undef PG8_WAIT_V
#undef PG8_WAIT_L
#undef PG8_BAR
#undef PG8_SCHED
}
}
#define LAS __attribute__((address_space(3)))
typedef unsigned short bf16;
typedef short bf16x8 __attribute__((ext_vector_type(8)));
typedef short s16x4 __attribute__((ext_vector_type(4)));
typedef float f32x4 __attribute__((ext_vector_type(4)));
typedef float f32x16 __attribute__((ext_vector_type(16)));
typedef unsigned u32x4 __attribute__((ext_vector_type(4)));
typedef unsigned u32x2 __attribute__((ext_vector_type(2)));
constexpr int NB = 16, SEQ = 2048, DM = 1024, MTOK = NB * SEQ, NH = 16, HD = 64, NG = 4;
constexpr int NSA_W = 2608, NSA_P = 2816, SB_P = 3072, DFF = 2816, DFF2 = 5632;
constexpr float LOG2E = 1.4426950408889634f, LN2 = 0.6931471805599453f;
constexpr size_t MiB = 1u << 20;
constexpr size_t WS_WNSA = 0, WS_WSB = 12 * MiB, WS_WOUT = 24 * MiB, WS_W13 = 32 * MiB, WS_W2 = 76 * MiB, WS_CW1 = 98 * MiB, WS_CW2 = 102 * MiB,
                 WS_CBIAS = 102 * MiB + 256 * 1024, WS_KC = 103 * MiB, WS_VCT = 104 * MiB, WS_SS = 105 * MiB, WS_GATES = 107 * MiB, WS_HB = 114 * MiB,
                 WS_O = 178 * MiB, WS_PROJ = 242 * MiB, WS_CTL = 436 * MiB, WS_END = 437 * MiB;
constexpr int LDS_BYTES = 147456 + 1024;
#ifndef TSEL
#define TSEL -1
#endif

struct Params { const float* in[15]; float* out; unsigned char* ws; int ph_lo, ph_hi; };

__device__ __forceinline__ unsigned f2bf(float f) { unsigned u = __builtin_bit_cast(unsigned, f); return (u + 0x7fffu + ((u >> 16) & 1u)) >> 16; }
__device__ __forceinline__ unsigned pk2(float lo, float hi) { return pg8::cvt_pk_bf16(lo, hi); }
__device__ __forceinline__ float wave_sum(float v) {
#pragma unroll
    for (int o = 1; o < 64; o <<= 1) v += __shfl_xor(v, o);
    return v;
}
__device__ __forceinline__ float swap32(float v) {
    const unsigned u = __builtin_bit_cast(unsigned, v);
    auto rr = __builtin_amdgcn_permlane32_swap(u, u, false, false);
    return __builtin_bit_cast(float, (threadIdx.x & 32) ? (unsigned)rr[0] : (unsigned)rr[1]);
}
__device__ __forceinline__ int crow(int r, int hi) { return (r & 3) + 8 * (r >> 2) + 4 * hi; }
__device__ __forceinline__ bf16x8 pack8(float a0, float a1, float a2, float a3, float a4, float a5, float a6, float a7) {
    u32x4 w; w.x = pk2(a0, a1); w.y = pk2(a2, a3); w.z = pk2(a4, a5); w.w = pk2(a6, a7); return __builtin_bit_cast(bf16x8, w);
}
typedef short v4i16_t __attribute__((ext_vector_type(4)));
__device__ __forceinline__ s16x4 vtr(const LAS unsigned char* p) { return __builtin_bit_cast(s16x4, __builtin_amdgcn_ds_read_tr16_b64_v4i16((LAS v4i16_t*)p)); }
#define MFMA32(a, b, c) __builtin_amdgcn_mfma_f32_32x32x16_bf16((a), (b), (c), 0, 0, 0)
#define MFMA16(a, b, c) __builtin_amdgcn_mfma_f32_16x16x32_bf16((a), (b), (c), 0, 0, 0)
#define LDS_FENCE() asm volatile("s_waitcnt lgkmcnt(0)" ::: "memory")

struct TrDesc { const float* W; int K, N; bf16* WT; int ldt; const float* ks; float qscale; int qcols; int mode; };
__device__ __forceinline__ void transpose_item(const TrDesc& d, LAS float* scr, int item, int lane) {
    const int nblk = (d.N + 31) >> 5, kb = item / nblk, nb = item - kb * nblk, k0 = 64 * kb, n0 = 32 * nb;
    const int nn = n0 + (lane & 31);
    float tv[32];
#pragma unroll
    for (int i = 0; i < 32; ++i) { const int kk = 2 * i + (lane >> 5); tv[i] = (nn < d.N) ? d.W[(size_t)(k0 + kk) * d.N + nn] : 0.f; }
    if (d.ks) {
#pragma unroll
        for (int i = 0; i < 32; ++i) tv[i] *= d.ks[k0 + 2 * i + (lane >> 5)];
    }
#pragma unroll
    for (int i = 0; i < 32; ++i) scr[(2 * i + (lane >> 5)) * 33 + (lane & 31)] = tv[i];
    LDS_FENCE();
    const int c = lane & 7;
#pragma unroll
    for (int j = 0; j < 4; ++j) {
        const int nl = (lane >> 3) + 8 * j, n = n0 + nl; const LAS float* s = scr + (8 * c) * 33 + nl;
        const float sc = (n < d.qcols) ? d.qscale : 1.0f;
        u32x4 o; o.x = pk2(s[0 * 33] * sc, s[1 * 33] * sc); o.y = pk2(s[2 * 33] * sc, s[3 * 33] * sc); o.z = pk2(s[4 * 33] * sc, s[5 * 33] * sc); o.w = pk2(s[6 * 33] * sc, s[7 * 33] * sc);
        const int row = d.mode == 0 ? n : (256 * (n >> 7) + (n & 127) + (d.mode == 2 ? 128 : 0));
        const size_t dst = (d.mode == 3) ? ((size_t)((k0 >> 6) * d.N + n) * 64 + 8 * c) : ((size_t)row * d.ldt + k0 + 8 * c);
        if (n < d.N) *(u32x4*)(d.WT + dst) = o;
    }
    LDS_FENCE();
}

__device__ __forceinline__ void prologue(const Params& p, LAS unsigned char* lds, int G) {
    int tid_ = threadIdx.x; asm volatile("" : "+v"(tid_)); const int tid = tid_, lane = tid & 63, wave = __builtin_amdgcn_readfirstlane(tid >> 6);
    LAS float* scr = (LAS float*)(lds + wave * 16384);
    const int gw = blockIdx.x * 8 + wave, NGW = G * 8;
    unsigned char* ws = p.ws;
    const float* mixg = p.in[1]; const float* ffng = p.in[2];
    { constexpr int IT = 16 * 82;
      for (int it = gw; it < 2 * IT; it += NGW) { const int j = it / IT, r = it - j * IT;
        TrDesc d{p.in[4] + (size_t)j * DM * NSA_W, DM, NSA_W, (bf16*)(ws + WS_WNSA) + (size_t)j * NSA_P * DM, DM, mixg + (2 * j) * DM, 0.125f * LOG2E, 1024, 0};
        transpose_item(d, scr, r, lane); } }
    { constexpr int IT = 16 * 96;
      for (int it = gw; it < 2 * IT; it += NGW) { const int j = it / IT, r = it - j * IT;
        TrDesc d{p.in[10] + (size_t)j * DM * SB_P, DM, SB_P, (bf16*)(ws + WS_WSB) + (size_t)j * SB_P * DM, DM, mixg + (2 * j + 1) * DM, 0.125f * LOG2E, 1024, 0};
        transpose_item(d, scr, r, lane); } }
    { constexpr int IT = 16 * 32;
      for (int it = gw; it < 4 * IT; it += NGW) { const int i = it / IT, r = it - i * IT;
        const float* W = ((i & 1) ? p.in[11] : p.in[9]) + (size_t)(i >> 1) * DM * DM;
        TrDesc d{W, DM, DM, (bf16*)(ws + WS_WOUT) + (size_t)i * DM * DM, DM, nullptr, 1.f, 0, 0};
        transpose_item(d, scr, r, lane); } }
    { constexpr int IT = 16 * 88;
      for (int it = gw; it < 8 * IT; it += NGW) { const int q = it / IT, r = it - q * IT, i = q & 3, which = q >> 2;
        TrDesc d{(which ? p.in[13] : p.in[12]) + (size_t)i * DM * DFF, DM, DFF, (bf16*)(ws + WS_W13) + (size_t)i * DFF2 * DM, DM, ffng + i * DM, 1.f, 0, which ? 2 : 1};
        transpose_item(d, scr, r, lane); } }
    { constexpr int IT = 44 * 32;
      for (int it = gw; it < 4 * IT; it += NGW) { const int i = it / IT, r = it - i * IT;
        TrDesc d{p.in[14] + (size_t)i * DFF * DM, DFF, DM, (bf16*)(ws + WS_W2) + (size_t)i * DM * DFF, DFF, nullptr, 1.f, 0, 0};
        transpose_item(d, scr, r, lane); } }
    { constexpr int IT = 32 * 8;
      for (int it = gw; it < 4 * IT; it += NGW) { const int q = it / IT, r = it - q * IT;
        TrDesc d{p.in[7] + (size_t)q * 2048 * 256, 2048, 256, (bf16*)(ws + WS_CW1) + (size_t)q * 256 * 2048, 2048, nullptr, 1.f, 0, 3};
        transpose_item(d, scr, r, lane); } }
    { constexpr int IT = 4 * 2;
      for (int it = gw; it < 4 * IT; it += NGW) { const int q = it / IT, r = it - q * IT;
        TrDesc d{p.in[8] + (size_t)q * 256 * 64, 256, 64, (bf16*)(ws + WS_CW2) + (size_t)q * 64 * 256, 256, nullptr, 1.f, 0, 0};
        transpose_item(d, scr, r, lane); } }
    { const float* x = p.in[0]; bf16* hb = (bf16*)(ws + WS_HB); float* ss = (float*)(ws + WS_SS);
      for (int m0 = gw * 4; m0 < MTOK; m0 += NGW * 4) {
        f32x4 v[4][4]; float sm[4];
#pragma unroll
        for (int q = 0; q < 4; ++q) { const f32x4* xr = (const f32x4*)(x + (size_t)(m0 + q) * DM) + lane;
#pragma unroll
          for (int j = 0; j < 4; ++j) v[q][j] = xr[64 * j]; }
#pragma unroll
        for (int q = 0; q < 4; ++q) { float t = 0.f;
#pragma unroll
          for (int j = 0; j < 4; ++j) t += (v[q][j][0] * v[q][j][0] + v[q][j][1] * v[q][j][1]) + (v[q][j][2] * v[q][j][2] + v[q][j][3] * v[q][j][3]);
          sm[q] = wave_sum(t); }
#pragma unroll
        for (int q = 0; q < 4; ++q) { u32x2* o8 = (u32x2*)(hb + (size_t)(m0 + q) * DM) + lane;
#pragma unroll
          for (int j = 0; j < 4; ++j) { u32x2 w; w.x = pk2(v[q][j][0], v[q][j][1]); w.y = pk2(v[q][j][2], v[q][j][3]); o8[64 * j] = w; } }
        { const int q = lane >> 4, c = lane & 15; const float tot = q == 0 ? sm[0] : q == 1 ? sm[1] : q == 2 ? sm[2] : sm[3]; ss[(size_t)(m0 + q) * 16 + c] = (c == 0) ? tot : 0.f; }
      } }
    { float* part = (float*)(ws + WS_CBIAS);
      for (int t = gw; t < 4 * 32; t += NGW) { const int q = t >> 5, kc = t & 31;
        const float* pe = p.in[6] + (size_t)q * 2048 + kc * 64; const float* W = p.in[7] + (size_t)q * 2048 * 256 + (size_t)kc * 64 * 256;
        f32x4 a = {0.f, 0.f, 0.f, 0.f};
#pragma unroll 16
        for (int k = 0; k < 64; ++k) { const float e = pe[k]; const f32x4 w = *((const f32x4*)(W + (size_t)k * 256) + lane); a += w * e; }
        *((f32x4*)(part + (size_t)(q * 32 + kc) * 256) + lane) = a; } }
    { const int gt = blockIdx.x * 512 + tid, NT = G * 512; constexpr int PER = (NSA_P - NSA_W) * DM * 2 / 16;
      for (int i = gt; i < 2 * PER; i += NT) { const int j = i / PER, r = i - j * PER;
        *((u32x4*)((bf16*)(ws + WS_WNSA) + (size_t)j * NSA_P * DM + (size_t)NSA_W * DM) + r) = (u32x4){0u, 0u, 0u, 0u}; } }
}

__device__ __forceinline__ float gelu_tanh(float v) {
    const float u = 0.7978845608028654f * (v + 0.044715f * v * v * v);
    const float t = 1.0f - 2.0f / (1.0f + __expf(2.0f * u));
    return 0.5f * v * (1.0f + t);
}
__device__ __forceinline__ void compress_phase(const Params& p, LAS unsigned char* lds, int G, int layerj) {
    int tid_ = threadIdx.x; asm volatile("" : "+v"(tid_)); const int tid = tid_, lane = tid & 63, w = __builtin_amdgcn_readfirstlane(tid >> 6), l15 = lane & 15, l4 = lane >> 4;
    unsigned char* ws = p.ws;
    const bf16* proj = (const bf16*)(ws + WS_PROJ);
    LAS bf16* hid = (LAS bf16*)lds;
    for (int unit = blockIdx.x; unit < 256; unit += G) {
        const int kv = unit & 1, half = (unit >> 1) & 1, bg = unit >> 2, b = bg >> 2, g = bg & 3, n0 = half * 64;
        const int q = layerj * 2 + kv;
        const bf16* w1t = (const bf16*)(ws + WS_CW1) + (size_t)q * 256 * 2048;
        const bf16* w2t = (const bf16*)(ws + WS_CW2) + (size_t)q * 64 * 256;
        const float* part = (const float*)(ws + WS_CBIAS) + (size_t)q * 32 * 256;
        const int colbase = (kv ? 1280 : 1024) + g * 64;
        LAS unsigned char* abuf = lds + 36864;
        const bf16* asrc = proj + (size_t)(b * SEQ + 16 * (n0 + (tid >> 3))) * NSA_P + colbase + (tid & 7) * 8;
        const int awr = (tid >> 3) * 144 + (tid & 7) * 16;
        const LAS unsigned char* ard = abuf + l15 * 144 + l4 * 16;
        const bf16* bsrc = w1t + (size_t)(32 * w + l15) * 64 + l4 * 8;
        LAS float* biasl = (LAS float*)(lds + 64 * 264 * 2);
        if (tid < 256) { float pv[32];
#pragma unroll
            for (int kc = 0; kc < 32; ++kc) pv[kc] = part[kc * 256 + tid];
            float bsum = 0.f;
#pragma unroll
            for (int kc = 0; kc < 32; ++kc) bsum += pv[kc];
            biasl[tid] = bsum; }
        f32x4 acc[4][2];
#pragma unroll
        for (int rb = 0; rb < 4; ++rb)
#pragma unroll
            for (int cb = 0; cb < 2; ++cb) acc[rb][cb] = (f32x4){0.f, 0.f, 0.f, 0.f};
        u32x4 ga; bf16x8 fb[2][2][2];
#define CMP_LOADB(buf, l) do { _Pragma("unroll") for (int ks = 0; ks < 2; ++ks) _Pragma("unroll") for (int cb = 0; cb < 2; ++cb) \
            fb[buf][ks][cb] = *(const bf16x8*)(bsrc + (size_t)(l) * 256 * 64 + cb * 16 * 64 + ks * 32); } while (0)
#define CMP_STEP(buf, l) do { \
            bf16x8 fa[2][4]; \
            _Pragma("unroll") for (int ks = 0; ks < 2; ++ks) _Pragma("unroll") for (int rb = 0; rb < 4; ++rb) fa[ks][rb] = *(const LAS bf16x8*)(ard + (buf) * 9216 + rb * 16 * 144 + ks * 64); \
            _Pragma("unroll") for (int ks = 0; ks < 2; ++ks) _Pragma("unroll") for (int rb = 0; rb < 4; ++rb) _Pragma("unroll") for (int cb = 0; cb < 2; ++cb) \
                acc[rb][cb] = MFMA16(fa[ks][rb], fb[buf][ks][cb], acc[rb][cb]); \
            if ((l) + 1 < 32) *(LAS u32x4*)(abuf + ((buf) ^ 1) * 9216 + awr) = ga; \
            if ((l) + 2 < 32) { ga = *(const u32x4*)(asrc + (size_t)((l) + 2) * NSA_P); CMP_LOADB(buf, (l) + 2); } \
            __syncthreads(); } while (0)
        ga = *(const u32x4*)asrc; CMP_LOADB(0, 0);
        *(LAS u32x4*)(abuf + awr) = ga;
        ga = *(const u32x4*)(asrc + NSA_P); CMP_LOADB(1, 1);
        __syncthreads();
#pragma unroll 1
        for (int l = 0; l < 32; l += 2) { CMP_STEP(0, l); CMP_STEP(1, l + 1); }
#undef CMP_LOADB
#undef CMP_STEP
        __syncthreads();
#pragma unroll
        for (int cb = 0; cb < 2; ++cb) {
            const int col = 32 * w + 16 * cb + l15; const float bias = biasl[col];
#pragma unroll
            for (int rb = 0; rb < 4; ++rb)
#pragma unroll
                for (int j = 0; j < 4; ++j) hid[(16 * rb + l4 * 4 + j) * 264 + col] = (bf16)f2bf(gelu_tanh(acc[rb][cb][j] + bias));
        }
        __syncthreads();
        const int rb2 = w >> 1;
        f32x4 o2[2] = {(f32x4){0.f, 0.f, 0.f, 0.f}, (f32x4){0.f, 0.f, 0.f, 0.f}};
#pragma unroll
        for (int ks = 0; ks < 8; ++ks) {
            const bf16x8 a = *(const LAS bf16x8*)(hid + (16 * rb2 + l15) * 264 + ks * 32 + l4 * 8);
#pragma unroll
            for (int c2 = 0; c2 < 2; ++c2) {
                const int cb = 2 * (w & 1) + c2;
                const bf16x8 bb = *(const bf16x8*)(w2t + (size_t)(16 * cb + l15) * 256 + ks * 32 + l4 * 8);
                o2[c2] = MFMA16(a, bb, o2[c2]);
            }
        }
#pragma unroll
        for (int c2 = 0; c2 < 2; ++c2) {
            const int d = 16 * (2 * (w & 1) + c2) + l15, nb = n0 + 16 * rb2 + l4 * 4;
            float v[4];
#pragma unroll
            for (int j = 0; j < 4; ++j) v[j] = (nb + j == 127) ? 0.f : o2[c2][j];
            if (kv == 0) {
                bf16* kc = (bf16*)(ws + WS_KC) + (size_t)((b * 4 + g) * 128) * 64;
#pragma unroll
                for (int j = 0; j < 4; ++j) kc[(size_t)(nb + j) * 64 + d] = (bf16)f2bf(v[j]);
            } else {
                bf16* vct = (bf16*)(ws + WS_VCT) + (size_t)((b * 4 + g) * 64 + d) * 128 + nb;
                u32x2 wv; wv.x = pk2(v[0], v[1]); wv.y = pk2(v[2], v[3]); *(u32x2*)vct = wv;
            }
        }
        __syncthreads();
    }
}
#if TSEL >= 9
#define SECT_INIT() unsigned long long t_sect = __builtin_amdgcn_s_memrealtime()
#define SECT(k) do { if (blockIdx.x == 0 && tid == 0) { const unsigned long long t_now = __builtin_amdgcn_s_memrealtime(); ((LAS unsigned long long*)(lds + 147456 + 800))[k] += t_now - t_sect; t_sect = t_now; } } while (0)
#else
#define SECT_INIT() do {} while (0)
#define SECT(k) do {} while (0)
#endif
struct AttnState { float m, l; f32x16 o0, o1; };
constexpr int KV_BUF = 16384;
template <bool ELEM_MASK>
__device__ __forceinline__ void attn_tile(AttnState& st, const LAS unsigned char* qrl, const LAS unsigned char* kb, const LAS unsigned char* vb,
                                          float base, float slope2, int key0, int tq, int lo_q, int r32, int hi, int lane, bool first) {
    const LAS unsigned char* vp = vb + (4 * hi + ((lane & 15) >> 2)) * 64 + ((lane >> 4) & 1) * 32 + (lane & 3) * 8;
    const int rel = tq - key0 - 4 * hi, rello = lo_q - key0 - 4 * hi;
    f32x16 p0, p1;
    const float hbm = (base + slope2 * (float)(4 * hi)) - st.m;
#pragma unroll
    for (int r = 0; r < 16; ++r) { const int cr = (r & 3) + 8 * (r >> 2); p0[r] = hbm + slope2 * (float)cr; p1[r] = hbm + slope2 * (float)(cr + 32); }
#pragma unroll
    for (int d0 = 0; d0 < 4; ++d0) {
        const bf16x8 k0 = *(const LAS bf16x8*)(kb + (2 * d0 + hi) * 1024 + r32 * 16);
        const bf16x8 k1 = *(const LAS bf16x8*)(kb + (2 * d0 + hi) * 1024 + 512 + r32 * 16);
        const bf16x8 qf = *(const LAS bf16x8*)(qrl + d0 * 1024);
        p0 = MFMA32(k0, qf, p0); p1 = MFMA32(k1, qf, p1);
    }
    float mx = -INFINITY;
#pragma unroll
    for (int r = 0; r < 16; ++r) {
        if (ELEM_MASK) { const int cr = (r & 3) + 8 * (r >> 2); p0[r] = (cr <= rel && cr >= rello) ? p0[r] : -INFINITY; p1[r] = (cr + 32 <= rel && cr + 32 >= rello) ? p1[r] : -INFINITY; }
        mx = fmaxf(mx, fmaxf(p0[r], p1[r]));
    }
    mx = fmaxf(mx, swap32(mx));
    if (!first && __all(mx < -30.f)) return;
    if (first || __any(mx > 0.f)) {
        const float delta = first ? (mx > -1e30f ? mx : 0.f) : fmaxf(mx, 0.f);
        const float alpha = __builtin_amdgcn_exp2f(-delta);
        st.m += delta; st.l *= alpha;
#pragma unroll
        for (int r = 0; r < 16; ++r) { st.o0[r] *= alpha; st.o1[r] *= alpha; p0[r] -= delta; p1[r] -= delta; }
    }
    float rs = 0.f;
#pragma unroll
    for (int r = 0; r < 16; ++r) { p0[r] = __builtin_amdgcn_exp2f(p0[r]); p1[r] = __builtin_amdgcn_exp2f(p1[r]); rs += p0[r] + p1[r]; }
    st.l += rs;
    bf16x8 pb[4];
    pb[0] = pack8(p0[0], p0[1], p0[2], p0[3], p0[4], p0[5], p0[6], p0[7]);
    pb[1] = pack8(p0[8], p0[9], p0[10], p0[11], p0[12], p0[13], p0[14], p0[15]);
    pb[2] = pack8(p1[0], p1[1], p1[2], p1[3], p1[4], p1[5], p1[6], p1[7]);
    pb[3] = pack8(p1[8], p1[9], p1[10], p1[11], p1[12], p1[13], p1[14], p1[15]);
#pragma unroll
    for (int ks = 0; ks < 4; ++ks) {
        const s16x4 a0 = vtr(vp + ks * 1024), a1 = vtr(vp + ks * 1024 + 512), c0 = vtr(vp + 4096 + ks * 1024), c1 = vtr(vp + 4096 + ks * 1024 + 512);
        const bf16x8 v0 = __builtin_shufflevector(a0, a1, 0, 1, 2, 3, 4, 5, 6, 7);
        const bf16x8 v1 = __builtin_shufflevector(c0, c1, 0, 1, 2, 3, 4, 5, 6, 7);
        st.o0 = MFMA32(v0, pb[ks], st.o0); st.o1 = MFMA32(v1, pb[ks], st.o1);
    }
}

constexpr int CMPV_PITCH = 264, IMP_OFF = 34816, SELM_OFF = IMP_OFF + 4 * 64 * 33 * 4, OACC_OFF = SELM_OFF + 256;
__device__ __forceinline__ void nsa_tiles(AttnState& st, LAS unsigned char* lds, unsigned tilesS, unsigned tilesW, const bf16* kvbase  ,
                                          unsigned mysel, float slope2, int tq, int qt, int lane, int w, u32x4 kA, u32x4 vA, float gate_s  ) {
    asm volatile("" : "+v"(lane));
    const int r32 = lane & 31, hi = lane >> 5;
    const LAS unsigned char* qrl = lds + IMP_OFF + w * 4096 + lane * 16;
    const bf16* ksrc = kvbase + (size_t)lane * NSA_P + w * 8;
    const bf16* vsrc = kvbase + 256 + (size_t)(16 * (w & 3) + (lane >> 2)) * NSA_P + (w >> 2) * 32 + (lane & 3) * 8;
    const int sto = w * 1024 + lane * 16;
    unsigned remS = tilesS & ~(1u << qt), remW = tilesW;
#define NSA_POP(code) do { if (remS) { const int j_ = 31 - __builtin_clz(remS); remS &= ~(1u << j_); code = j_; } \
                          else if (remW) { const int j_ = 31 - __builtin_clz(remW); remW &= ~(1u << j_); code = 32 + j_; } else code = -1; } while (0)
#define NSA_FETCH(KR, VR, code) do { const int cc_ = (code) >= 0 ? (code) : qt;     \
        const size_t off_ = (size_t)(cc_ & 31) * 64 * NSA_P + (cc_ >> 5) * 512; KR = *(const u32x4*)(ksrc + off_); VR = *(const u32x4*)(vsrc + off_); } while (0)
    int c0 = qt, c1, c2; bool first = true;
    u32x4 kB, vB;
    NSA_POP(c1); NSA_FETCH(kB, vB, c1);
    *(LAS u32x4*)(lds + sto) = kA; *(LAS u32x4*)(lds + 8192 + sto) = vA;
    __syncthreads();
    int buf = 0;
#define NSA_STEP(KN, VN, KF, VF) do { \
        NSA_POP(c2); NSA_FETCH(KF, VF, c2); \
        { const int phase = c0 >> 5, j = c0 & 31; \
          const LAS unsigned char* kb = lds + buf * KV_BUF; const LAS unsigned char* vb = kb + 8192; \
          const bool selq = phase ? true : (((mysel >> j) & 1u) != 0u); \
          const float base = selq ? slope2 * (float)(64 * j - tq) : -INFINITY; \
          const int lo_q = phase ? tq - 511 : -(1 << 30); \
          if (j == qt || (phase && j == qt - 8)) attn_tile<true>(st, qrl, kb, vb, base, slope2, 64 * j, tq, lo_q, r32, hi, lane, first); \
          else attn_tile<false>(st, qrl, kb, vb, base, slope2, 64 * j, tq, lo_q, r32, hi, lane, false); } \
        { LAS unsigned char* nb = lds + (buf ^ 1) * KV_BUF; *(LAS u32x4*)(nb + sto) = KN; *(LAS u32x4*)(nb + 8192 + sto) = VN; }     \
        __syncthreads(); \
        first = false; \
        if (c1 >= 0 && (c1 >> 5) != (c0 >> 5)) {     \
            first = true; \
            LAS float* oacc2 = (LAS float*)(lds + OACC_OFF) + w * 2048 + lane; \
            const float lt = st.l + swap32(st.l); const float sc = gate_s / lt; \
            _Pragma("unroll") for (int r = 0; r < 16; ++r) { oacc2[r * 64] += st.o0[r] * sc; oacc2[(16 + r) * 64] += st.o1[r] * sc; } \
            st.m = 0.f; st.l = 0.f; \
            _Pragma("unroll") for (int r = 0; r < 16; ++r) { st.o0[r] = 0.f; st.o1[r] = 0.f; } } \
        c0 = c1; c1 = c2; buf ^= 1; } while (0)
    for (;;) {
        NSA_STEP(kB, vB, kA, vA);
        if (c0 < 0) break;
        NSA_STEP(kA, vA, kB, vB);
        if (c0 < 0) break;
    }
#undef NSA_POP
#undef NSA_FETCH
#undef NSA_STEP
}

__device__ __forceinline__ void nsa_attn_phase(const Params& p, LAS unsigned char* lds, int G) {
    int tid_ = threadIdx.x; asm volatile("" : "+v"(tid_)); const int tid = tid_, lane = tid & 63, w = __builtin_amdgcn_readfirstlane(tid >> 6), r32 = lane & 31, hi = lane >> 5, hh = w & 3, tb = w >> 2;
    unsigned char* ws = p.ws;
    const bf16* proj = (const bf16*)(ws + WS_PROJ);
    const float* gates = (const float*)(ws + WS_GATES);
    bf16* obuf = (bf16*)(ws + WS_O);
    LAS float* impw = (LAS float*)(lds + IMP_OFF);
    LAS unsigned* selm = (LAS unsigned*)(lds + SELM_OFF);
    for (int u = blockIdx.x; u < 2048; u += G) {
        SECT_INIT();
        int bg, qt;
        if (G == 256) { const int r = u >> 8, k = u & 255, c = k >> 6; bg = (k & 63) ^ (r & 3); qt = (r & 1) ? 4 * r + 3 - c : 4 * r + c; }
        else { bg = u & 63; qt = u >> 6; }
        const int b = bg >> 2, g = bg & 3, head = 4 * g + hh;
        const float slope2 = __builtin_amdgcn_exp2f(-0.5f * (float)(head + 1)) * LOG2E;
        const int tq = 64 * qt + 32 * tb + r32; const size_t row = (size_t)b * SEQ + tq;
        bf16x8 qr[4];
        { const bf16* qp = proj + row * NSA_P + head * 64 + hi * 8;
#pragma unroll
          for (int d0 = 0; d0 < 4; ++d0) qr[d0] = *(const bf16x8*)(qp + d0 * 16); }
        const float gate_c = gates[row * 48 + head], gate_s = gates[row * 48 + 16 + head], gate_w = gates[row * 48 + 32 + head];
        LAS float* oacc = (LAS float*)(lds + OACC_OFF) + w * 2048 + lane;
        const bf16* kvbase = proj + (size_t)b * SEQ * NSA_P + 1536 + g * 64;
        const u32x4 kreg0 = *(const u32x4*)(kvbase + (size_t)(64 * qt + lane) * NSA_P + w * 8);
        const u32x4 vreg0 = *(const u32x4*)(kvbase + 256 + (size_t)(64 * qt + 16 * (w & 3) + (lane >> 2)) * NSA_P + (w >> 2) * 32 + (lane & 3) * 8);
        {
            const int nct = (4 * qt + 3 + 31) >> 5;
            const bf16* kcb = (const bf16*)(ws + WS_KC) + (size_t)((b * 4 + g) * 128) * 64;
            const bf16* vctb = (const bf16*)(ws + WS_VCT) + (size_t)((b * 4 + g) * 64) * 128;
            {
                u32x4 kk[2], vv[2];
#pragma unroll
                for (int i = 0; i < 2; ++i) { const int id = tid + 512 * i; kk[i] = *(const u32x4*)(kcb + (size_t)(id >> 3) * 64 + (id & 7) * 8); vv[i] = *(const u32x4*)(vctb + (size_t)(id >> 4) * 128 + (id & 15) * 8); }
#pragma unroll
                for (int i = 0; i < 2; ++i) { const int id = tid + 512 * i;
                    *(LAS u32x4*)(lds + (id & 7) * 2048 + (id >> 3) * 16) = kk[i];
                    LAS unsigned char* vd = lds + 16384 + (id >> 4) * CMPV_PITCH + (id & 15) * 16;
                    *(LAS u32x2*)vd = (u32x2){vv[i].x, vv[i].y}; *(LAS u32x2*)(vd + 8) = (u32x2){vv[i].z, vv[i].w}; }
            }
            __syncthreads();
            const LAS unsigned char* kcl = lds + hi * 2048 + r32 * 16;
            const LAS unsigned char* vcl = lds + 16384 + r32 * CMPV_PITCH + 8 * hi;
            float m = -1e30f, l = 0.f;
#pragma unroll 1
            for (int t = 0; t < nct; ++t) {
                f32x16 a;
#pragma unroll
                for (int r = 0; r < 16; ++r) a[r] = 0.f;
#pragma unroll
                for (int d0 = 0; d0 < 4; ++d0) { const bf16x8 kf = *(const LAS bf16x8*)(kcl + d0 * 4096 + t * 512); a = MFMA32(kf, qr[d0], a); }
                float mx = -INFINITY;
#pragma unroll
                for (int r = 0; r < 16; ++r) { const int n = 32 * t + crow(r, hi), cend = 16 * n + 31; const float sv = a[r] + slope2 * (float)(cend - tq); a[r] = (cend <= tq) ? sv : -INFINITY; mx = fmaxf(mx, a[r]); }
                mx = fmaxf(mx, swap32(mx));
                const float mnew = fmaxf(m, mx); float rs = 0.f;
#pragma unroll
                for (int r = 0; r < 16; ++r) rs += __builtin_amdgcn_exp2f(a[r] - mnew);
                l = l * __builtin_amdgcn_exp2f(m - mnew) + rs; m = mnew;
            }
            l += swap32(l);
            const float inv = (l > 0.f) ? 1.0f / l : 0.f;
            LAS float* myimp = impw + (hh * 64 + tb * 32 + r32) * 33;
            float carry3 = 0.f;
            f32x16 out0, out1;
#pragma unroll
            for (int r = 0; r < 16; ++r) { out0[r] = 0.f; out1[r] = 0.f; }
#pragma unroll 1
            for (int t = 0; t < nct; ++t) {
                f32x16 a;
#pragma unroll
                for (int r = 0; r < 16; ++r) a[r] = 0.f;
#pragma unroll
                for (int d0 = 0; d0 < 4; ++d0) { const bf16x8 kf = *(const LAS bf16x8*)(kcl + d0 * 4096 + t * 512); a = MFMA32(kf, qr[d0], a); }
#pragma unroll
                for (int r = 0; r < 16; ++r) { const int n = 32 * t + crow(r, hi), cend = 16 * n + 31; const float sv = a[r] + slope2 * (float)(cend - tq); a[r] = (cend <= tq) ? __builtin_amdgcn_exp2f(sv - m) * inv : 0.f; }
                float rcv[4];
#pragma unroll
                for (int i = 0; i < 4; ++i) rcv[i] = swap32(a[4 * i + 3]);
#pragma unroll
                for (int i = 0; i < 4; ++i) {
                    const float own = 2.0f * (a[4 * i] + a[4 * i + 1] + a[4 * i + 2]) + a[4 * i + 3];
                    const float prev = hi ? rcv[i] : (i == 0 ? carry3 : rcv[i - 1]);
                    myimp[8 * t + 2 * i + hi] = own + prev;
                }
                carry3 = rcv[3];
#pragma unroll
                for (int ks = 0; ks < 2; ++ks) {
                    const bf16x8 pbk = pack8(a[8 * ks], a[8 * ks + 1], a[8 * ks + 2], a[8 * ks + 3], a[8 * ks + 4], a[8 * ks + 5], a[8 * ks + 6], a[8 * ks + 7]);
                    const LAS unsigned char* v0p = vcl + t * 64 + ks * 32;
                    const s16x4 a0 = *(const LAS s16x4*)v0p, a1 = *(const LAS s16x4*)(v0p + 16), c0 = *(const LAS s16x4*)(v0p + 32 * CMPV_PITCH), c1 = *(const LAS s16x4*)(v0p + 32 * CMPV_PITCH + 16);
                    const bf16x8 v0 = __builtin_shufflevector(a0, a1, 0, 1, 2, 3, 4, 5, 6, 7);
                    const bf16x8 v1 = __builtin_shufflevector(c0, c1, 0, 1, 2, 3, 4, 5, 6, 7);
                    out0 = MFMA32(v0, pbk, out0); out1 = MFMA32(v1, pbk, out1);
                }
            }
            const float gc = gate_c;
#pragma unroll
            for (int r = 0; r < 16; ++r) { oacc[r * 64] = out0[r] * gc; oacc[(16 + r) * 64] = out1[r] * gc; }
        }
        __syncthreads();
        SECT(0);
        for (int idx = tid; idx < 64 * 32; idx += 512) { const int q = idx >> 5, jj = idx & 31; LAS float* a = impw + q * 33 + jj;
            a[0] = (a[0] + a[64 * 33]) + (a[2 * 64 * 33] + a[3 * 64 * 33]); }
        __syncthreads();
        if (qt + 1 <= 8) { if (tid < 64) selm[tid] = (1u << (qt + 1)) - 1u; }
        else {
#pragma unroll 1
            for (int it = 0; it < 4; ++it) {
                const int q = 8 * w + 2 * it + hi, jj = r32;
                const LAS float* rowp = impw + q * 33;
                const float my = rowp[jj]; int cnt = 0;
                float rv[32];
#pragma unroll
                for (int j2 = 0; j2 < 32; ++j2) rv[j2] = rowp[j2];
#pragma unroll
                for (int j2 = 1; j2 < 31; ++j2) cnt += (j2 <= qt - 2 && (rv[j2] > my || (rv[j2] == my && j2 < jj))) ? 1 : 0;
                const bool forced = (jj == 0) || (jj == qt) || (jj == qt - 1);
                const bool cand = (jj >= 1) && (jj <= qt - 2);
                const bool sel = forced || (cand && cnt < 5);
                const unsigned long long bal = __ballot(sel);
                if (r32 == 0) selm[q] = hi ? (unsigned)(bal >> 32) : (unsigned)bal;
            }
        }
        __syncthreads();
        const unsigned mysel = selm[tb * 32 + r32];
        unsigned uni = selm[lane];
#pragma unroll
        for (int o = 1; o < 64; o <<= 1) uni |= __shfl_xor(uni, o);
        uni = __builtin_amdgcn_readfirstlane(uni);
        LAS unsigned char* qrl = lds + IMP_OFF + w * 4096 + lane * 16;
#pragma unroll
        for (int d0 = 0; d0 < 4; ++d0) *(LAS bf16x8*)(qrl + d0 * 1024) = qr[d0];
        SECT(1);
        {
            AttnState st; st.m = 0.f; st.l = 0.f;
#pragma unroll
            for (int r = 0; r < 16; ++r) { st.o0[r] = 0.f; st.o1[r] = 0.f; }
            const int jlo = qt >= 8 ? qt - 8 : 0;
            const unsigned tilesW = (unsigned)(((1ull << (qt + 1)) - 1ull) & ~((1ull << jlo) - 1ull));
            nsa_tiles(st, lds, uni, tilesW, kvbase, mysel, slope2, tq, qt, lane, w, kreg0, vreg0, gate_s);
            SECT(2);
            int l2 = lane; asm volatile("" : "+v"(l2)); const size_t row2 = (size_t)b * SEQ + 64 * qt + 32 * tb + (l2 & 31); LAS float* oacc2 = (LAS float*)(lds + OACC_OFF) + w * 2048 + l2;
            const float lt = st.l + swap32(st.l); const float sc = gate_w / lt;
            f32x16 out0, out1;
#pragma unroll
            for (int r = 0; r < 16; ++r) { out0[r] = oacc2[r * 64] + st.o0[r] * sc; out1[r] = oacc2[(16 + r) * 64] + st.o1[r] * sc; }
          bf16* op = obuf + row2 * DM + head * 64 + 4 * (l2 >> 5);
#pragma unroll
          for (int i = 0; i < 4; ++i) {
            u32x2 w0; w0.x = pk2(out0[4 * i], out0[4 * i + 1]); w0.y = pk2(out0[4 * i + 2], out0[4 * i + 3]); *(u32x2*)(op + 8 * i) = w0;
            u32x2 w1; w1.x = pk2(out1[4 * i], out1[4 * i + 1]); w1.y = pk2(out1[4 * i + 2], out1[4 * i + 3]); *(u32x2*)(op + 32 + 8 * i) = w1; } }
        SECT(3);
    }
}
__device__ __forceinline__ void sb_attn_phase(const Params& p, LAS unsigned char* lds, int G) {
    int tid_ = threadIdx.x; asm volatile("" : "+v"(tid_)); const int tid = tid_, lane = tid & 63, w = __builtin_amdgcn_readfirstlane(tid >> 6), r32 = lane & 31, hi = lane >> 5;
    unsigned char* ws = p.ws;
    const bf16* proj = (const bf16*)(ws + WS_PROJ);
    bf16* obuf = (bf16*)(ws + WS_O);
    LAS unsigned char* vl = lds + w * 4096;
    const LAS unsigned char* vp = vl + (4 * hi + ((lane & 15) >> 2)) * 64 + ((lane >> 4) & 1) * 32 + (lane & 3) * 8;
    const int gw = blockIdx.x * 8 + w, NGW = G * 8;
    for (int u = gw; u < NB * NH * 64; u += NGW) {
        const int qb = u & 63, head = (u >> 6) & 15, b = u >> 10;
        const int tq = 32 * qb + r32; const size_t row = (size_t)b * SEQ + tq;
        bf16x8 qr[4];
        { const bf16* qp = proj + row * SB_P + head * 64 + hi * 8;
#pragma unroll
          for (int d0 = 0; d0 < 4; ++d0) qr[d0] = *(const bf16x8*)(qp + d0 * 16); }
        const bf16* kbase = proj + (size_t)b * SEQ * SB_P + 1024 + head * 64;
        const bf16* vbase = proj + (size_t)b * SEQ * SB_P + 2048 + head * 64;
        f32x16 o0, o1;
#pragma unroll
        for (int r = 0; r < 16; ++r) { o0[r] = 0.f; o1[r] = 0.f; }
        float carry = 0.f;
        u32x4 vrA[4], vrB[4]; bf16x8 kfA[4], kfB[4];
#define SB_LOAD(VR, KF, kt_) do { const int key0_ = 32 * (kt_); \
            _Pragma("unroll") for (int i = 0; i < 4; ++i) { const int idx = i * 64 + lane, db = idx >> 7, key = (idx >> 2) & 31, c4 = idx & 3; \
                VR[i] = *(const u32x4*)(vbase + (size_t)(key0_ + key) * SB_P + 32 * db + 8 * c4); } \
            _Pragma("unroll") for (int d0 = 0; d0 < 4; ++d0) KF[d0] = *(const bf16x8*)(kbase + (size_t)(key0_ + r32) * SB_P + d0 * 16 + hi * 8); } while (0)
#define SB_TILE(VR, KF, kt_, DG) do { const int key0 = 32 * (kt_); \
            f32x16 z; \
            _Pragma("unroll") for (int r = 0; r < 16; ++r) z[r] = 0.f; \
            _Pragma("unroll") for (int d0 = 0; d0 < 4; ++d0) z = MFMA32(KF[d0], qr[d0], z); \
            LDS_FENCE(); \
            _Pragma("unroll") for (int i = 0; i < 4; ++i) *(LAS u32x4*)(vl + (i * 64 + lane) * 16) = VR[i]; \
              \
            float L[16]; \
            _Pragma("unroll") for (int r = 0; r < 16; ++r) { \
                const float zz = z[r]; \
                const float sp = fmaxf(zz, 0.f) + __builtin_amdgcn_logf(1.0f + __builtin_amdgcn_exp2f(-fabsf(zz))); \
                L[r] = (!(DG) || (key0 + crow(r, hi)) < tq) ? -sp : 0.f; } \
            float gsum[4], og[4], T[4]; \
            _Pragma("unroll") for (int i = 0; i < 4; ++i) { gsum[i] = (L[4 * i] + L[4 * i + 1]) + (L[4 * i + 2] + L[4 * i + 3]); og[i] = swap32(gsum[i]); T[i] = gsum[i] + og[i]; } \
            float R[4]; R[3] = 0.f; R[2] = T[3]; R[1] = T[3] + T[2]; R[0] = R[1] + T[1]; \
            float a[16]; \
            _Pragma("unroll") for (int i = 0; i < 4; ++i) { \
                const float A = carry + R[i] + (hi ? 0.f : og[i]); \
                const float s3 = A, s2 = s3 + L[4 * i + 3], s1 = s2 + L[4 * i + 2], s0 = s1 + L[4 * i + 1]; \
                const float suf[4] = {s0, s1, s2, s3}; \
                _Pragma("unroll") for (int e4 = 0; e4 < 4; ++e4) { const int r = 4 * i + e4; const float ev = __builtin_amdgcn_exp2f(z[r] + L[r] + suf[e4]); \
                    a[r] = (!(DG) || (key0 + crow(r, hi)) < tq) ? ev : 0.f; } } \
            carry += R[0] + T[0]; \
            const bf16x8 pb0 = pack8(a[0], a[1], a[2], a[3], a[4], a[5], a[6], a[7]), pb1 = pack8(a[8], a[9], a[10], a[11], a[12], a[13], a[14], a[15]); \
            LDS_FENCE(); \
            _Pragma("unroll") for (int ks = 0; ks < 2; ++ks) { \
                const s16x4 a0 = vtr(vp + ks * 1024), a1 = vtr(vp + ks * 1024 + 512), c0 = vtr(vp + 2048 + ks * 1024), c1 = vtr(vp + 2048 + ks * 1024 + 512); \
                const bf16x8 v0 = __builtin_shufflevector(a0, a1, 0, 1, 2, 3, 4, 5, 6, 7); \
                const bf16x8 v1 = __builtin_shufflevector(c0, c1, 0, 1, 2, 3, 4, 5, 6, 7); \
                o0 = MFMA32(v0, ks ? pb1 : pb0, o0); o1 = MFMA32(v1, ks ? pb1 : pb0, o1); } } while (0)
#define SB_DONE(kt_) ((kt_) == 0 || __all(carry < -30.0f))
        SB_LOAD(vrA, kfA, qb);
        if (qb > 0) SB_LOAD(vrB, kfB, qb - 1);
        SB_TILE(vrA, kfA, qb, 1);
        if (!SB_DONE(qb)) {
            for (int kt = qb - 1;;) {
                if (kt > 0) SB_LOAD(vrA, kfA, kt - 1);
                SB_TILE(vrB, kfB, kt, 0);
                if (SB_DONE(kt)) break;
                --kt;
                if (kt > 0) SB_LOAD(vrB, kfB, kt - 1);
                SB_TILE(vrA, kfA, kt, 0);
                if (SB_DONE(kt)) break;
                --kt;
            }
        }
#undef SB_DONE
#undef SB_LOAD
#undef SB_TILE
        LDS_FENCE();
        { bf16* op = obuf + row * DM + head * 64 + 4 * hi;
#pragma unroll
          for (int i = 0; i < 4; ++i) {
            u32x2 w0; w0.x = pk2(o0[4 * i], o0[4 * i + 1]); w0.y = pk2(o0[4 * i + 2], o0[4 * i + 3]); *(u32x2*)(op + 8 * i) = w0;
            u32x2 w1; w1.x = pk2(o1[4 * i], o1[4 * i + 1]); w1.y = pk2(o1[4 * i + 2], o1[4 * i + 3]); *(u32x2*)(op + 32 + 8 * i) = w1; } }
    }
}

__device__ __forceinline__ void final_norm_phase(const Params& p, int G) {
    int tid_ = threadIdx.x; asm volatile("" : "+v"(tid_));
    const int lane = tid_ & 63, gw = blockIdx.x * 8 + __builtin_amdgcn_readfirstlane(tid_ >> 6), NGW = G * 8;
    const float* ss = (const float*)(p.ws + WS_SS); const float* g = p.in[3]; const bf16* hb = (const bf16*)(p.ws + WS_HB);
    f32x4 gv[4];
#pragma unroll
    for (int j = 0; j < 4; ++j) gv[j] = *((const f32x4*)g + lane + 64 * j);
    for (int m0 = gw * 2; m0 < MTOK; m0 += NGW * 2) {
        u32x2 hv[2][4]; float rs[2];
#pragma unroll
        for (int q = 0; q < 2; ++q) { rs[q] = pg8::row_rstd(ss, m0 + q);
#pragma unroll
          for (int j = 0; j < 4; ++j) hv[q][j] = *((const u32x2*)(hb + (size_t)(m0 + q) * DM) + lane + 64 * j); }
#pragma unroll
        for (int q = 0; q < 2; ++q) { f32x4* xr = (f32x4*)(p.out + (size_t)(m0 + q) * DM) + lane;
#pragma unroll
          for (int j = 0; j < 4; ++j) { f32x4 v; v[0] = __builtin_bit_cast(float, hv[q][j].x << 16); v[1] = __builtin_bit_cast(float, hv[q][j].x & 0xffff0000u);
            v[2] = __builtin_bit_cast(float, hv[q][j].y << 16); v[3] = __builtin_bit_cast(float, hv[q][j].y & 0xffff0000u); xr[64 * j] = v * rs[q] * gv[j]; } }
    }
}

#define XB_TMO      128
#define XB_XCNT(j)  (256  + 64 * (j))
#define XB_XSUB(j)  (1280 + 64 * (j))
#define XB_XGEN(j)  (2304 + 64 * (j))
#define XB_TOP      3328
#define XB_TOPGEN   3392
#define XCD_BAR_WORDS 3456
#define XB_SPIN_CAP (1u << 18)

__device__ __forceinline__ unsigned xb_ld(unsigned* p)              { return __hip_atomic_load(p, __ATOMIC_RELAXED, __HIP_MEMORY_SCOPE_AGENT); }
__device__ __forceinline__ unsigned xb_add(unsigned* p, unsigned v) { return __hip_atomic_fetch_add(p, v, __ATOMIC_RELAXED, __HIP_MEMORY_SCOPE_AGENT); }
__device__ __forceinline__ unsigned xb_xcc_id() { return (unsigned)__builtin_amdgcn_s_getreg((3 << 11) | 20) & 0xFu; }
#define XB_SPIN(cond, bar) do { unsigned _sp = 0; while (cond) { __builtin_amdgcn_s_sleep(1); \
    if ((++_sp & 255u) == 0u) { if (xb_ld(&(bar)[XB_TMO])) break; if (_sp > XB_SPIN_CAP) { atomicAdd(&(bar)[XB_TMO], 1u); break; } } } } while (0)

struct XcdBarrier {
    unsigned* bar; unsigned x;
    volatile LAS unsigned* st;
};

__device__ __forceinline__ XcdBarrier xcd_barrier_post(unsigned* bar, volatile LAS unsigned* st) {
    XcdBarrier b; b.bar = bar; b.x = xb_xcc_id(); b.st = st;
    if (threadIdx.x == 0) (void)xb_add(&bar[XB_XCNT(b.x)], 1u);
    return b;
}
__device__ __forceinline__ void xcd_barrier_complete(unsigned* bar, unsigned x, unsigned& nloc, unsigned& nx) {
    const unsigned G = gridDim.x * gridDim.y * gridDim.z;
    unsigned sum, cnt, mine, sp = 0u;
    for (;;) {
        sum = 0u; cnt = 0u; mine = 0u;
#pragma unroll
        for (unsigned j = 0; j < 16; ++j) { const unsigned c = xb_ld(&bar[XB_XCNT(j)]); sum += c; cnt += (c > 0u) ? 1u : 0u; mine = (j == x) ? c : mine; }
        if (sum == G) break;
        __builtin_amdgcn_s_sleep(1);
        if ((++sp & 255u) == 0u) { if (xb_ld(&bar[XB_TMO])) break; if (sp > XB_SPIN_CAP) { atomicAdd(&bar[XB_TMO], 1u); break; } }
    }
    nloc = mine > 0u ? mine : 1u; nx = cnt > 0u ? cnt : 1u;
}

__device__ __forceinline__ void xcd_barrier(const XcdBarrier& b) {
    asm volatile("s_waitcnt vmcnt(0)" ::: "memory");
    __syncthreads();
    if (threadIdx.x == 0) {
        unsigned* bar = b.bar;
        __builtin_amdgcn_s_waitcnt(0);
        unsigned nloc = b.st[0], nx = b.st[1];
        if (nloc == 0u) { xcd_barrier_complete(bar, b.x, nloc, nx); b.st[0] = nloc; b.st[1] = nx; }
        const unsigned old = xb_add(&bar[XB_XSUB(b.x)], 1u);
        const unsigned gen = old / nloc;
        if (old + 1u == (gen + 1u) * nloc) {
            __builtin_amdgcn_fence(__ATOMIC_RELEASE, "agent");
            asm volatile("s_waitcnt vmcnt(0)" ::: "memory");
            const unsigned og = xb_add(&bar[XB_TOP], 1u);
            const unsigned tg = og / nx;
            if (og + 1u == (tg + 1u) * nx) xb_add(&bar[XB_TOPGEN], 1u);
            else XB_SPIN(xb_ld(&bar[XB_TOPGEN]) == tg, bar);
            __builtin_amdgcn_fence(__ATOMIC_ACQUIRE, "agent");
            xb_add(&bar[XB_XGEN(b.x)], 1u);
            asm volatile("s_waitcnt vmcnt(0)" ::: "memory");
        } else {
            XB_SPIN(xb_ld(&bar[XB_XGEN(b.x)]) == gen, bar);
            __builtin_amdgcn_fence(__ATOMIC_ACQUIRE, "agent");
            asm volatile("s_waitcnt vmcnt(0)" ::: "memory");
        }
    }
    __syncthreads();
}

__global__ void __launch_bounds__(512, 2) mega(Params p) {
    extern __shared__ __attribute__((aligned(16))) unsigned char lds_raw[];
    LAS unsigned char* lds = (LAS unsigned char*)lds_raw;
    cg::grid_group grid = cg::this_grid();
    const int G = gridDim.x;
    unsigned char* ws = p.ws;
    bf16* hb = (bf16*)(ws + WS_HB); bf16* proj = (bf16*)(ws + WS_PROJ); bf16* obuf = (bf16*)(ws + WS_O);
    float* ss = (float*)(ws + WS_SS); float* gates = (float*)(ws + WS_GATES);
    volatile LAS unsigned* bst = (volatile LAS unsigned*)(lds + 147456 + 768);
    if (threadIdx.x < 2) bst[threadIdx.x] = 0u;
    if (threadIdx.x < 8) ((LAS unsigned long long*)(lds + 147456 + 800))[threadIdx.x] = 0ull;
    __syncthreads();
    XcdBarrier bar = xcd_barrier_post((unsigned*)(ws + WS_CTL), bst);
    int ph = 0;
    LAS unsigned long long* tsl = (LAS unsigned long long*)(lds + 147456);
    LAS int* kindl = (LAS int*)(lds + 147456 + 512);
    const bool stamper = (TSEL >= 0) && blockIdx.x == 0 && threadIdx.x == 0;
    if (stamper) tsl[0] = __builtin_amdgcn_s_memrealtime();
#define PHASE_ON (ph >= p.ph_lo && ph < p.ph_hi)
#define PHASE_END(kind) do { if (ph >= p.ph_lo && ph + 1 < p.ph_hi) { if (ph == 0) grid.sync(); else xcd_barrier(bar); } if (stamper) { tsl[ph + 1] = __builtin_amdgcn_s_memrealtime(); kindl[ph] = (kind); } ++ph; } while (0)
    if (PHASE_ON) prologue(p, lds, G);
    PHASE_END(0);
#pragma unroll 1
    for (int i = 0; i < 4; ++i) {
        const bool nsa = !(i & 1); const int j = i >> 1;
        if (PHASE_ON) {
            const bf16* Wt = nsa ? (const bf16*)(ws + WS_WNSA) + (size_t)j * NSA_P * DM : (const bf16*)(ws + WS_WSB) + (size_t)j * SB_P * DM;
            const int N = nsa ? NSA_P : SB_P;
            pg8::Gemm g{hb, Wt, MTOK, N, DM}; pg8::StaticOrder S; S.init(MTOK, N, G, (int)blockIdx.x);
            pg8::EpiProj E{proj, N, ss, p.in[5] + j * 48, gates, nsa ? 2560 : (1 << 30)};
            pg8::gemm_phase<pg8::EpiProj, pg8::StaticOrder, true, true>(lds, g, S, E);
        }
        PHASE_END(1);
        if (nsa) {
            if (PHASE_ON) compress_phase(p, lds, G, j);
            PHASE_END(2);
            if (PHASE_ON) nsa_attn_phase(p, lds, G);
            PHASE_END(3);
        } else {
            if (PHASE_ON) sb_attn_phase(p, lds, G);
            PHASE_END(4);
        }
#pragma unroll 1
        for (int s = 0; s < 2; ++s) {
            if (PHASE_ON) {
                const bf16* A = s == 0 ? obuf : proj;
                const bf16* Wt = s == 0 ? (const bf16*)(ws + WS_WOUT) + (size_t)i * DM * DM : (const bf16*)(ws + WS_W2) + (size_t)i * DM * DFF;
                pg8::Gemm g{A, Wt, MTOK, DM, s == 0 ? DM : DFF}; pg8::StaticOrder S; S.init(MTOK, DM, G, (int)blockIdx.x);
                pg8::EpiResid E{hb, ss};
                pg8::gemm_phase<pg8::EpiResid, pg8::StaticOrder, true, true>(lds, g, S, E);
            }
            PHASE_END(5);
            if (s == 0) {
                if (PHASE_ON) {
                    pg8::Gemm g{hb, (const bf16*)(ws + WS_W13) + (size_t)i * DFF2 * DM, MTOK, DFF2, DM}; pg8::StaticOrder S; S.init(MTOK, DFF2, G, (int)blockIdx.x);
                    pg8::EpiSwiGLU E{proj, ss};
                    pg8::gemm_phase<pg8::EpiSwiGLU, pg8::StaticOrder, true, true>(lds, g, S, E);
                }
                PHASE_END(6);
            }
        }
    }
    if (TSEL == 8) { for (int q = 0; q < 10; ++q) { PHASE_END(8); } }
    if (PHASE_ON) final_norm_phase(p, G);
    if (TSEL >= 0) {
        grid.sync();
        if (stamper) { tsl[ph + 1] = __builtin_amdgcn_s_memrealtime(); kindl[ph] = 7; }
        if (blockIdx.x == 0) {
            __syncthreads();
            unsigned long long T = 0;
            for (int k = 0; k <= ph; ++k) if (kindl[k] == TSEL) T += tsl[k + 1] - tsl[k];
            if (TSEL >= 9) T = ((LAS unsigned long long*)(lds + 147456 + 800))[TSEL - 9];
            const int K = (int)(T / 100);
            for (int r = threadIdx.x; r < K && r < MTOK; r += 512) p.out[(size_t)r * DM + 7] += 0.1f;
        }
    }
}

extern "C" void kernel_launch(void* const* d_in, const int* in_sizes, int n_in, void* d_out, int out_size, void* d_ws, size_t ws_size, hipStream_t stream) {
    static int grid = 0;
    if (grid == 0) {
        if (n_in != 15 || out_size != MTOK * DM || ws_size < WS_END) { fprintf(stderr, "kernel_launch: unexpected shapes (n_in %d out %d ws %zu)\n", n_in, out_size, ws_size); grid = -1; return; }
        int dev = 0, cus = 0, per_cu = 0;
        if (hipGetDevice(&dev) != hipSuccess || hipDeviceGetAttribute(&cus, hipDeviceAttributeMultiprocessorCount, dev) != hipSuccess) { grid = -1; return; }
        if (hipFuncSetAttribute((const void*)mega, hipFuncAttributeMaxDynamicSharedMemorySize, LDS_BYTES) != hipSuccess) { fprintf(stderr, "hipFuncSetAttribute failed\n"); grid = -1; return; }
        if (hipOccupancyMaxActiveBlocksPerMultiprocessor(&per_cu, mega, 512, LDS_BYTES) != hipSuccess || per_cu < 1) { fprintf(stderr, "occupancy query failed\n"); grid = -1; return; }
        grid = cus;
    }
    if (grid <= 0) return;
    Params p{};
    for (int i = 0; i < 15; ++i) p.in[i] = (const float*)d_in[i];
    p.out = (float*)d_out; p.ws = (unsigned char*)d_ws; p.ph_lo = 0; p.ph_hi = 1000;
    if (hipMemsetAsync((unsigned char*)d_ws + WS_CTL, 0, XCD_BAR_WORDS * sizeof(unsigned), stream) != hipSuccess) { fprintf(stderr, "memset failed\n"); return; }
    void* args[] = {&p};
    hipError_t e = hipLaunchCooperativeKernel((void*)mega, dim3(grid), dim3(512), args, LDS_BYTES, stream);
    if (e != hipSuccess) fprintf(stderr, "cooperative launch failed: %s (grid %d)\n", hipGetErrorString(e), grid);
}
```
